# Optimizing an MI355X kernel written in HIP

```python
import math
import jax, jax.numpy as jnp
from jax import lax
import numpy as np

D_MODEL = 1024
BATCH = 32
SEQ = 256
DEPTH = 2
DEC_BATCH = 8
DEC_SEQ = 1024
PAST_LEN = 512

GRID_W = 64
NA_HEADS = 8
HEAD_DIM = 64
NA_WIDTH = NA_HEADS * HEAD_DIM
NA_MAX_ROWS = 8
NA_COLS = 16
NA_BAND = 2 * NA_COLS
S5_GROUPS = 16
S5_GROUP_CH = 16
S5_WIDTH = S5_GROUPS * S5_GROUP_CH
S5_STATE = 64
LRU_WIDTH = 256
LRU_BLOCKS = 4
LRU_BLOCK = LRU_WIDTH // LRU_BLOCKS
LRU_C = 8.0
LRU_CONV = 4
FFN_DIM = 2816
FFN_CONV = 3
ATTN_BLOCK = 128
N_BRANCH = 3
IN_SPLITS = (NA_WIDTH, 2 * NA_WIDTH, 3 * NA_WIDTH, 3 * NA_WIDTH + S5_WIDTH,
             3 * NA_WIDTH + S5_WIDTH + LRU_WIDTH, 3 * NA_WIDTH + S5_WIDTH + 2 * LRU_WIDTH)
IN_WIDTH = 3 * NA_WIDTH + S5_WIDTH + 2 * LRU_WIDTH + N_BRANCH * D_MODEL
EPS = 1e-6
NEG_INF = -1e30

kernel_name = "hybrid_flow_na_s5_rglru_step"


def rms_norm(x, g):
    x32 = x.astype(jnp.float32)
    y = x32 * lax.rsqrt(jnp.mean(x32 * x32, axis=-1, keepdims=True) + EPS)
    return y.astype(x.dtype) * g


def dw_conv(x, w, b, pad_left, pad_right):
    ch = x.shape[-1]
    y = lax.conv_general_dilated(x, w[:, None, :].astype(x.dtype), window_strides=(1,),
                                 padding=[(pad_left, pad_right)],
                                 dimension_numbers=('NWC', 'WIO', 'NWC'), feature_group_count=ch)
    return y + b


def linear_scan(a, b, h0, reverse):
    if reverse:
        a, b = jnp.flip(a, axis=1), jnp.flip(b, axis=1)

    def combine(left, right):
        a1, b1 = left
        a2, b2 = right
        return a1 * a2, a2 * b1 + b2

    a_cum, h_cum = lax.associative_scan(combine, (a, b), axis=1)
    h = h_cum + a_cum * h0[:, None]
    h_last = h[:, -1]
    if reverse:
        h = jnp.flip(h, axis=1)
    return h, h_last


def context_attention(q, k, v):
    bsz, length, heads, dh = q.shape
    nb = length // ATTN_BLOCK
    qb = (q * HEAD_DIM ** -0.5).reshape(bsz, nb, ATTN_BLOCK, heads, dh).swapaxes(0, 1)

    def block(qi):
        s = jnp.einsum('bqhd,bkhd->bhqk', qi, k).astype(jnp.float32)
        p = jax.nn.softmax(s, axis=-1).astype(v.dtype)
        return jnp.einsum('bhqk,bkhd->bqhd', p, v)

    out = lax.map(block, qb)
    return out.swapaxes(0, 1).reshape(bsz, length, heads * dh)


def neighbourhood_attention(q, k, v, k_ctx, v_ctx, rpb):
    bsz, length, heads, dh = q.shape
    rows = length // GRID_W
    wr = min(NA_MAX_ROWS, rows)
    ncb = GRID_W // NA_COLS
    r = jnp.arange(rows)
    row_idx = jnp.clip(r - wr // 2, 0, rows - wr)[:, None] + jnp.arange(wr)
    band0 = jnp.clip(jnp.arange(ncb) * NA_COLS - NA_COLS // 2, 0, GRID_W - NA_BAND)
    col_idx = band0[:, None] + jnp.arange(NA_BAND)
    qcol = jnp.arange(GRID_W).reshape(ncb, NA_COLS)
    win0 = jnp.clip(qcol - NA_COLS // 2, 0, GRID_W - NA_COLS)
    kc = col_idx[:, None, :]
    in_win = (kc >= win0[..., None]) & (kc < win0[..., None] + NA_COLS)
    dy = row_idx - r[:, None] + NA_MAX_ROWS - 1
    dx = jnp.clip(kc - qcol[..., None] + NA_COLS - 1, 0, 2 * NA_COLS - 2)
    bias = rpb[:, dy[:, None, None, :, None], dx[None, :, :, None, :]].astype(jnp.float32)

    k_grid = k.reshape(bsz, rows, GRID_W, heads, dh)
    v_grid = v.reshape(bsz, rows, GRID_W, heads, dh)
    gi_r = row_idx[:, :, None, None]
    gi_c = col_idx[None, None]
    kg = k_grid[:, gi_r, gi_c]
    vg = v_grid[:, gi_r, gi_c]
    qg = (q * HEAD_DIM ** -0.5).reshape(bsz, rows, ncb, NA_COLS, heads, dh)

    s_loc = jnp.einsum('brjqhd,brwjkhd->bhrjqwk', qg, kg).astype(jnp.float32) + bias
    s_loc = jnp.where(in_win[:, :, None, :], s_loc, NEG_INF)
    s_ctx = jnp.einsum('brjqhd,bchd->bhrjqc', qg, k_ctx).astype(jnp.float32)
    n_loc = wr * NA_BAND
    s = jnp.concatenate([s_loc.reshape(bsz, heads, rows, ncb, NA_COLS, n_loc), s_ctx], axis=-1)
    p = jax.nn.softmax(s, axis=-1).astype(v.dtype)
    p_loc = p[..., :n_loc].reshape(bsz, heads, rows, ncb, NA_COLS, wr, NA_BAND)
    out = (jnp.einsum('bhrjqwk,brwjkhd->brjqhd', p_loc, vg)
           + jnp.einsum('bhrjqc,bchd->brjqhd', p[..., n_loc:], v_ctx))
    return out.reshape(bsz, length, heads * dh)


def s5_mixer(u, lp, h0):
    bsz, length, _ = u.shape
    f32 = jnp.float32
    u32 = u.astype(f32).reshape(bsz, length, S5_GROUPS, S5_GROUP_CH)
    lam = lax.complex(lp['s5_lam_re'].astype(f32), lp['s5_lam_im'].astype(f32))
    step = jnp.exp(lp['s5_log_step'].astype(f32))[..., None]
    lam_bar = jnp.exp(lam * step)
    b_mat = lax.complex(lp['s5_b_re'].astype(f32), lp['s5_b_im'].astype(f32))
    b_bar = ((lam_bar - 1.0) / lam)[..., None] * b_mat[None]
    c_mat = lax.complex(lp['s5_c_re'].astype(f32), lp['s5_c_im'].astype(f32))
    bu = jnp.einsum('blgp,dgnp->dblgn', u32.astype(jnp.complex64), b_bar)
    y = lp['s5_d'].astype(f32).reshape(S5_GROUPS, S5_GROUP_CH) * u32
    finals = []
    for d, reverse in enumerate((False, True)):
        a = jnp.broadcast_to(lam_bar[d], bu[d].shape)
        h, h_last = linear_scan(a, bu[d], h0[:, d], reverse)
        y = y + jnp.einsum('blgn,gpn->blgp', h, c_mat[d]).real
        finals.append(h_last)
    y = jax.nn.gelu(y.reshape(bsz, length, S5_WIDTH))
    y = y * jax.nn.sigmoid(y @ lp['s5_w_glu'].astype(f32))
    return y.astype(u.dtype), jnp.stack(finals, axis=1)


def rglru_mixer(xr, gate, lp, h0):
    bsz, length, _ = xr.shape
    f32 = jnp.float32
    pad_l = LRU_CONV // 2
    xc = dw_conv(xr, lp['lru_conv_w'], lp['lru_conv_b'], pad_l, LRU_CONV - 1 - pad_l).astype(f32)
    xb = xc.reshape(bsz, length, LRU_BLOCKS, LRU_BLOCK)

    def block_diag_gate(w, b):
        y = jnp.einsum('blhi,dhij->dblhj', xb, w.astype(f32)).reshape(2, bsz, length, LRU_WIDTH)
        return jax.nn.sigmoid(y + b.astype(f32)[:, None, None, :])

    r = block_diag_gate(lp['lru_w_a'], lp['lru_b_a'])
    i = block_diag_gate(lp['lru_w_x'], lp['lru_b_x'])
    log_a = -LRU_C * r * jax.nn.softplus(-lp['lru_lam'].astype(f32))[:, None, None, :]
    a = jnp.exp(log_a)
    b = jnp.sqrt(-jnp.expm1(2.0 * log_a)) * (i * xc[None])
    h_f, last_f = linear_scan(a[0], b[0], h0[:, 0].astype(f32), False)
    h_b, last_b = linear_scan(a[1], b[1], h0[:, 1].astype(f32), True)
    y = (h_f + h_b) * jax.nn.gelu(gate.astype(f32))
    return y.astype(xr.dtype), jnp.stack([last_f, last_b], axis=1)


def token_mixer(h, lp, prefix):
    bsz, length, _ = h.shape
    z = h @ lp['w_in']
    q, k, v, u, xr, xg, g = jnp.split(z, IN_SPLITS, axis=-1)
    heads = (bsz, length, NA_HEADS, HEAD_DIM)
    q, k, v = q.reshape(heads), k.reshape(heads), v.reshape(heads)
    if prefix is None:
        attn = context_attention(q, k, v)
        s5_h0 = jnp.zeros((bsz, 2, S5_GROUPS, S5_STATE), jnp.complex64)
        lru_h0 = jnp.zeros((bsz, 2, LRU_WIDTH), jnp.float32)
    else:
        k_ctx, v_ctx, s5_h0, lru_h0 = prefix
        attn = neighbourhood_attention(q, k, v, k_ctx, v_ctx, lp['rpb'])
    s5_y, s5_last = s5_mixer(u, lp, s5_h0)
    lru_y, lru_last = rglru_mixer(xr, xg, lp, lru_h0)
    gates = jax.nn.sigmoid(g.reshape(bsz, length, N_BRANCH, D_MODEL).astype(jnp.float32)).astype(h.dtype)
    merged = (gates[:, :, 0] * (attn @ lp['w_br_attn'])
              + gates[:, :, 1] * (s5_y @ lp['w_br_s5'])
              + gates[:, :, 2] * (lru_y @ lp['w_br_lru']))
    return merged @ lp['w_out'], (k, v, s5_last, lru_last)


def conv_ffn(h, lp):
    a, b = jnp.split(h @ lp['ffn_w_up'], 2, axis=-1)
    a = dw_conv(a, lp['ffn_conv_w'], lp['ffn_conv_b'], FFN_CONV // 2, FFN_CONV - 1 - FFN_CONV // 2)
    return (jax.nn.gelu(a) * b) @ lp['ffn_w_down']


def layer(x, cond, lp, prefix):
    mod = jax.nn.silu(cond) @ lp['w_ada'] + lp['b_ada']
    sh1, sc1, gt1, sh2, sc2, gt2 = jnp.split(mod[:, None, :], 6, axis=-1)
    h = rms_norm(x, lp['g1']) * (1 + sc1) + sh1
    m, ctx_state = token_mixer(h, lp, prefix)
    x = x + gt1 * m
    h = rms_norm(x, lp['g2']) * (1 + sc2) + sh2
    x = x + gt2 * conv_ffn(h, lp)
    return x, ctx_state


def setup_inputs(seed: int = 0) -> dict:
    key = jax.random.key(seed)
    keys = iter(jax.random.split(key, 64))
    f32 = jnp.float32

    def nrm(shape, scale=1.0):
        return scale * jax.random.normal(next(keys), shape, f32)

    def unif(shape, lo, hi):
        return jax.random.uniform(next(keys), shape, f32, lo, hi)

    L = DEPTH
    n_idx = jnp.arange(S5_STATE, dtype=f32)
    lru_s = unif((L, 2, LRU_WIDTH), 0.9, 0.999) ** (1.0 / LRU_C)
    return {
        'x_prompt': nrm((BATCH, SEQ, D_MODEL)),
        'x_sample': nrm((DEC_BATCH, DEC_SEQ, D_MODEL)),
        'cache_k': nrm((DEC_BATCH, L, PAST_LEN, NA_HEADS, HEAD_DIM)),
        'cache_v': nrm((DEC_BATCH, L, PAST_LEN, NA_HEADS, HEAD_DIM)),
        'state_s5_re': nrm((DEC_BATCH, L, 2, S5_GROUPS, S5_STATE), 0.1),
        'state_s5_im': nrm((DEC_BATCH, L, 2, S5_GROUPS, S5_STATE), 0.1),
        'state_lru': nrm((DEC_BATCH, L, 2, LRU_WIDTH), 0.5),
        'c': nrm((DEC_BATCH, D_MODEL)),
        'c_ctx': nrm((D_MODEL,)),
        'w_ada': nrm((L, D_MODEL, 6 * D_MODEL), 0.5 * D_MODEL ** -0.5),
        'b_ada': nrm((L, 6 * D_MODEL), 0.01),
        'g_norm1': 1.0 + nrm((L, D_MODEL), 0.01),
        'g_norm2': 1.0 + nrm((L, D_MODEL), 0.01),
        'w_in': nrm((L, D_MODEL, IN_WIDTH), D_MODEL ** -0.5),
        'rpb': nrm((L, NA_HEADS, 2 * NA_MAX_ROWS - 1, 2 * NA_COLS - 1), 0.1),
        's5_lam_re': -0.5 + nrm((L, 2, S5_GROUPS, S5_STATE), 0.01),
        's5_lam_im': math.pi * n_idx + nrm((L, 2, S5_GROUPS, S5_STATE), 0.01),
        's5_log_step': jnp.log(unif((L, 2, S5_GROUPS), 0.001, 0.1)),
        's5_b_re': nrm((L, S5_GROUPS, S5_STATE, S5_GROUP_CH), (2 * S5_GROUP_CH) ** -0.5),
        's5_b_im': nrm((L, S5_GROUPS, S5_STATE, S5_GROUP_CH), (2 * S5_GROUP_CH) ** -0.5),
        's5_c_re': nrm((L, 2, S5_GROUPS, S5_GROUP_CH, S5_STATE), S5_STATE ** -0.5),
        's5_c_im': nrm((L, 2, S5_GROUPS, S5_GROUP_CH, S5_STATE), S5_STATE ** -0.5),
        's5_d': nrm((L, S5_WIDTH)),
        's5_w_glu': nrm((L, S5_WIDTH, S5_WIDTH), S5_WIDTH ** -0.5),
        'lru_conv_w': nrm((L, LRU_CONV, LRU_WIDTH), LRU_CONV ** -0.5),
        'lru_conv_b': nrm((L, LRU_WIDTH), 0.01),
        'lru_w_a': nrm((L, 2, LRU_BLOCKS, LRU_BLOCK, LRU_BLOCK), LRU_BLOCK ** -0.5),
        'lru_b_a': nrm((L, 2, LRU_WIDTH), 0.01),
        'lru_w_x': nrm((L, 2, LRU_BLOCKS, LRU_BLOCK, LRU_BLOCK), LRU_BLOCK ** -0.5),
        'lru_b_x': nrm((L, 2, LRU_WIDTH), 0.01),
        'lru_lam': jnp.log(lru_s) - jnp.log1p(-lru_s),
        'w_br_attn': nrm((L, NA_WIDTH, D_MODEL), NA_WIDTH ** -0.5),
        'w_br_s5': nrm((L, S5_WIDTH, D_MODEL), S5_WIDTH ** -0.5),
        'w_br_lru': nrm((L, LRU_WIDTH, D_MODEL), LRU_WIDTH ** -0.5),
        'w_out': nrm((L, D_MODEL, D_MODEL), D_MODEL ** -0.5),
        'ffn_w_up': nrm((L, D_MODEL, 2 * FFN_DIM), D_MODEL ** -0.5),
        'ffn_conv_w': nrm((L, FFN_CONV, FFN_DIM), FFN_CONV ** -0.5),
        'ffn_conv_b': nrm((L, FFN_DIM), 0.01),
        'ffn_w_down': nrm((L, FFN_DIM, D_MODEL), FFN_DIM ** -0.5),
        'g_final': 1.0 + nrm((D_MODEL,), 0.01),
    }


def reference(x_prompt, x_sample, cache_k, cache_v, state_s5_re, state_s5_im, state_lru, c, c_ctx,
              w_ada, b_ada, g_norm1, g_norm2, w_in, rpb,
              s5_lam_re, s5_lam_im, s5_log_step, s5_b_re, s5_b_im, s5_c_re, s5_c_im, s5_d, s5_w_glu,
              lru_conv_w, lru_conv_b, lru_w_a, lru_b_a, lru_w_x, lru_b_x, lru_lam,
              w_br_attn, w_br_s5, w_br_lru, w_out,
              ffn_w_up, ffn_conv_w, ffn_conv_b, ffn_w_down, g_final):
    f32 = jnp.float32
    yp, ys = x_prompt, x_sample
    ks, vs, s5r, s5i, lrus = [], [], [], [], []
    for l in range(DEPTH):
        lp = {
            'w_ada': w_ada[l], 'b_ada': b_ada[l], 'g1': g_norm1[l], 'g2': g_norm2[l],
            'w_in': w_in[l], 'rpb': rpb[l],
            's5_lam_re': s5_lam_re[l], 's5_lam_im': s5_lam_im[l], 's5_log_step': s5_log_step[l],
            's5_b_re': s5_b_re[l], 's5_b_im': s5_b_im[l], 's5_c_re': s5_c_re[l], 's5_c_im': s5_c_im[l],
            's5_d': s5_d[l], 's5_w_glu': s5_w_glu[l],
            'lru_conv_w': lru_conv_w[l], 'lru_conv_b': lru_conv_b[l],
            'lru_w_a': lru_w_a[l], 'lru_b_a': lru_b_a[l], 'lru_w_x': lru_w_x[l], 'lru_b_x': lru_b_x[l],
            'lru_lam': lru_lam[l],
            'w_br_attn': w_br_attn[l], 'w_br_s5': w_br_s5[l], 'w_br_lru': w_br_lru[l], 'w_out': w_out[l],
            'ffn_w_up': ffn_w_up[l], 'ffn_conv_w': ffn_conv_w[l], 'ffn_conv_b': ffn_conv_b[l],
            'ffn_w_down': ffn_w_down[l],
        }
        yp, (k_l, v_l, s5_last, lru_last) = layer(yp, c_ctx[None], lp, None)
        ks.append(k_l)
        vs.append(v_l)
        s5r.append(s5_last.real)
        s5i.append(s5_last.imag)
        lrus.append(lru_last)
        prefix = (cache_k[:, l], cache_v[:, l],
                  lax.complex(state_s5_re[:, l].astype(f32), state_s5_im[:, l].astype(f32)),
                  state_lru[:, l])
        ys, _ = layer(ys, c, lp, prefix)
    y_prompt = rms_norm(yp, g_final)
    y_sample = rms_norm(ys, g_final)
    return (y_prompt, y_sample, jnp.stack(ks, axis=1), jnp.stack(vs, axis=1),
            jnp.stack(s5r, axis=1), jnp.stack(s5i, axis=1), jnp.stack(lrus, axis=1))
```

```cpp
#include <hip/hip_runtime.h>
#include <hip/hip_cooperative_groups.h>
#include <stdint.h>
#include <cstdio>
namespace cg = cooperative_groups;

#define LAS __attribute__((address_space(3)))
typedef unsigned short bf16_t;
typedef short bf16x8 __attribute__((ext_vector_type(8)));
typedef float f32x4 __attribute__((ext_vector_type(4)));

struct Params {
  const float *x_prompt, *x_sample, *cache_k, *cache_v, *st_s5_re, *st_s5_im, *st_lru, *c, *c_ctx;
  const float *w_ada, *b_ada, *g1, *g2, *w_in, *rpb;
  const float *s5_lam_re, *s5_lam_im, *s5_log_step, *s5_b_re, *s5_b_im, *s5_c_re, *s5_c_im, *s5_d, *s5_w_glu;
  const float *lru_conv_w, *lru_conv_b, *lru_w_a, *lru_b_a, *lru_w_x, *lru_b_x, *lru_lam;
  const float *w_br_attn, *w_br_s5, *w_br_lru, *w_out, *ffn_w_up, *ffn_conv_w, *ffn_conv_b, *ffn_w_down, *g_final;
  float* out;
  char* ws;
};

#define OUT_NEWK 16777216
#define OUT_NEWV 25165824
#define OUT_S5RE 33554432
#define OUT_S5IM 33685504
#define OUT_LRU 33816576

#define WS_MOD 0
#define WS_WT 524288
#define WT_IN 0
#define WT_BRA 5505024
#define WT_BRS 6029312
#define WT_BRL 6291456
#define WT_OUT 6553600
#define WT_UP 7602176
#define WT_DOWN 13369344
#define WT_GLU 16252928
#define WT_LRU 16318464
#define WS_HBUF 33685504
#define WS_UB 67239936
#define UB_QB 0
#define UB_KB 16777216
#define UB_VTC 33554432
#define UB_VTL 41943040
#define UB_U 50331648
#define UB_XR 58720256
#define UB_XG 67108864
#define UB_S5Y 75497472
#define UB_LRUY 83886080
#define UB_MG 92274688
#define UB_KC 125829120
#define UB_VCT 130023424
#define UB_G8 134217728
#define UB_FA 0
#define UB_ACT 92274688
#define LDS_BYTES 132160
#ifndef PHASE_MASK
#define PHASE_MASK 0xffff
#endif
#define GSYNC() do { xcd_barrier(xb); if ((REP_MASK >> 14) & 1) xcd_barrier(xb); } while (0)
#ifndef REP_MASK
#define REP_MASK 0
#endif
#define PH(k) for (int rep_ = 0; rep_ < ((REP_MASK >> (k)) & 1) + 1; ++rep_) if (PHASE_MASK & (1 << (k)))
#define LAUNDER_TID() int tid = threadIdx.x; asm volatile("" : "+v"(tid)); const int lane = tid & 63, wave = tid >> 6, l15 = lane & 15, quad = lane >> 4; (void)lane; (void)wave; (void)l15; (void)quad

__device__ __forceinline__ uint32_t pack2(float a, float b) {
  uint32_t r;
  asm("v_cvt_pk_bf16_f32 %0, %1, %2" : "=v"(r) : "v"(a), "v"(b));
  return r;
}
__device__ __forceinline__ bf16_t f2bf(float f) { return (bf16_t)(pack2(f, 0.f) & 0xffffu); }
__device__ __forceinline__ float bf2f(bf16_t b) { return __uint_as_float(((uint32_t)b) << 16); }
__device__ __forceinline__ float lo2f(uint32_t u) { return __uint_as_float(u << 16); }
__device__ __forceinline__ float hi2f(uint32_t u) { return __uint_as_float(u & 0xffff0000u); }
__device__ __forceinline__ float sigmoidf_(float x) { return __builtin_amdgcn_rcpf(1.f + __expf(-x)); }
__device__ __forceinline__ float gelu_(float x) {
  float z = 0.7978845608028654f * (x + 0.044715f * x * x * x);
  float t = 1.f - 2.f * __builtin_amdgcn_rcpf(1.f + __expf(2.f * z));
  return 0.5f * x * (1.f + t);
}
__device__ __forceinline__ float quad_max(float x) {
  unsigned u = __float_as_uint(x);
  auto r = __builtin_amdgcn_permlane32_swap(u, u, false, false);
  float m = fmaxf(__uint_as_float(r[0]), __uint_as_float(r[1]));
  unsigned u2 = __float_as_uint(m);
  auto r2 = __builtin_amdgcn_permlane16_swap(u2, u2, false, false);
  return fmaxf(__uint_as_float(r2[0]), __uint_as_float(r2[1]));
}
__device__ __forceinline__ float quad_sum(float x) {
  unsigned u = __float_as_uint(x);
  auto r = __builtin_amdgcn_permlane32_swap(u, u, false, false);
  float m = __uint_as_float(r[0]) + __uint_as_float(r[1]);
  unsigned u2 = __float_as_uint(m);
  auto r2 = __builtin_amdgcn_permlane16_swap(u2, u2, false, false);
  return __uint_as_float(r2[0]) + __uint_as_float(r2[1]);
}
typedef float f32x4nt __attribute__((ext_vector_type(4)));
__device__ __forceinline__ float4 ld_nt4(const float* p) {
  f32x4nt v = __builtin_nontemporal_load((const f32x4nt*)p);
  return make_float4(v[0], v[1], v[2], v[3]);
}
__device__ __forceinline__ int modrow(int r) { return r < 8192 ? 0 : 1 + ((r - 8192) >> 10); }


#define WS_BAR 458752
#define XB_TMO      128
#define XB_XCNT(j)  (256  + 64 * (j))
#define XB_XSUB(j)  (1280 + 64 * (j))
#define XB_XGEN(j)  (2304 + 64 * (j))
#define XB_TOP      3328
#define XB_TOPGEN   3392
#define XB_WQ(i)    (3456 + 64 * (i))
#define XCD_BAR_WORDS 4096
#define XB_SPIN_CAP (1u << 18)
__device__ __forceinline__ unsigned xb_ld(unsigned* p) { return __hip_atomic_load(p, __ATOMIC_RELAXED, __HIP_MEMORY_SCOPE_AGENT); }
__device__ __forceinline__ unsigned xb_add(unsigned* p, unsigned v) { return __hip_atomic_fetch_add(p, v, __ATOMIC_RELAXED, __HIP_MEMORY_SCOPE_AGENT); }
__device__ __forceinline__ unsigned xb_xcc_id() { return (unsigned)__builtin_amdgcn_s_getreg((3 << 11) | 20) & 0xFu; }
#define XB_SPIN(cond, bar) do { unsigned _sp = 0; while (cond) { __builtin_amdgcn_s_sleep(1); \
    if ((++_sp & 255u) == 0u) { if (xb_ld(&(bar)[XB_TMO])) break; if (_sp > XB_SPIN_CAP) { atomicAdd(&(bar)[XB_TMO], 1u); break; } } } } while (0)
struct XcdBarrier { unsigned* bar; unsigned x; volatile LAS unsigned* st; };
__device__ __forceinline__ XcdBarrier xcd_barrier_post(unsigned* bar, volatile LAS unsigned* st) {
  XcdBarrier b; b.bar = bar; b.x = xb_xcc_id(); b.st = st;
  if (threadIdx.x == 0) (void)xb_add(&bar[XB_XCNT(b.x)], 1u);
  return b;
}
__device__ __forceinline__ void xcd_barrier_complete(unsigned* bar, unsigned x, unsigned& nloc, unsigned& nx) {
  const unsigned G = gridDim.x * gridDim.y * gridDim.z;
  unsigned sum, cnt, mine, sp = 0u;
  for (;;) {
    sum = 0u; cnt = 0u; mine = 0u;
#pragma unroll
    for (unsigned j = 0; j < 16; ++j) { const unsigned c = xb_ld(&bar[XB_XCNT(j)]); sum += c; cnt += (c > 0u) ? 1u : 0u; mine = (j == x) ? c : mine; }
    if (sum == G) break;
    __builtin_amdgcn_s_sleep(1);
    if ((++sp & 255u) == 0u) { if (xb_ld(&bar[XB_TMO])) break; if (sp > XB_SPIN_CAP) { atomicAdd(&bar[XB_TMO], 1u); break; } }
  }
  nloc = mine > 0u ? mine : 1u; nx = cnt > 0u ? cnt : 1u;
}
__device__ __forceinline__ void xcd_barrier(const XcdBarrier& b) {
  asm volatile("s_waitcnt vmcnt(0)" ::: "memory");
  __syncthreads();
  if (threadIdx.x == 0) {
    unsigned* bar = b.bar;
    __builtin_amdgcn_s_waitcnt(0);
    unsigned nloc = b.st[0], nx = b.st[1];
    if (nloc == 0u) { xcd_barrier_complete(bar, b.x, nloc, nx); b.st[0] = nloc; b.st[1] = nx; }
    const unsigned old = xb_add(&bar[XB_XSUB(b.x)], 1u);
    const unsigned gen = old / nloc;
    if (old + 1u == (gen + 1u) * nloc) {
      __builtin_amdgcn_fence(__ATOMIC_RELEASE, "agent");
      asm volatile("s_waitcnt vmcnt(0)" ::: "memory");
      const unsigned og = xb_add(&bar[XB_TOP], 1u);
      const unsigned tg = og / nx;
      if (og + 1u == (tg + 1u) * nx) xb_add(&bar[XB_TOPGEN], 1u);
      else XB_SPIN(xb_ld(&bar[XB_TOPGEN]) == tg, bar);
      __builtin_amdgcn_fence(__ATOMIC_ACQUIRE, "agent");
      xb_add(&bar[XB_XGEN(b.x)], 1u);
      asm volatile("s_waitcnt vmcnt(0)" ::: "memory");
    } else {
      XB_SPIN(xb_ld(&bar[XB_XGEN(b.x)]) == gen, bar);
      __builtin_amdgcn_fence(__ATOMIC_ACQUIRE, "agent");
      asm volatile("s_waitcnt vmcnt(0)" ::: "memory");
    }
  }
  __syncthreads();
}

namespace pg8 {
constexpr int BM = 256, BK = 64, HALF = 128, HTB = HALF * BK * 2, NXCD = 8, WGM = 8;
__device__ __forceinline__ int lds_byte(int r, int c) { const int st = (r >> 4) * 2 + (c >> 5), rr = r & 15, cc = c & 31, ob = rr * 64 + cc * 2; return st * 1024 + (ob ^ (((ob >> 9) & 1) << 5)); }
__device__ __forceinline__ void stage_rc(int b, int& R, int& C) { const int st = b / 1024, sb = b % 1024, swz = sb ^ (((sb >> 9) & 1) << 5); R = (st >> 1) * 16 + swz / 64; C = (st & 1) * 32 + (swz % 64) / 2; }
struct Unit { int pm, pn; };
struct Gemm { const bf16_t* A; const bf16_t* Bt; int lda, ldb, K; };
struct StaticOrder {
  int nM, nN, nwg, G, c;
  __device__ void init(int M, int N, int G_, int c_) { nM = M / BM; nN = N / BM; nwg = nM * nN; G = G_; c = c_; }
  __device__ bool next(int i, Unit& u) const {
    const long L = (long)i * G + c; if (L >= nwg) return false;
    int wgid = (int)L; { const int q = nwg / NXCD, r = nwg % NXCD, xcd = wgid % NXCD, off = wgid / NXCD; wgid = (xcd < r ? xcd * (q + 1) : r * (q + 1) + (xcd - r) * q) + off; }
    const int nig = WGM * nN, gid = wgid / nig, fm = gid * WGM, gsz = (nM - fm) < WGM ? (nM - fm) : WGM;
    u.pm = fm + ((wgid % nig) % gsz); u.pn = (wgid % nig) / gsz; return true;
  }
};

template <class Epi>
__device__ __forceinline__ void gemm_phase(LAS unsigned char* lds, const Gemm g, const StaticOrder& S, const Epi& E) {
  int tid = threadIdx.x; asm volatile("" : "+v"(tid));
  const int wid = __builtin_amdgcn_readfirstlane(tid >> 6), lane = tid & 63, wr = wid >> 2, wc = wid & 3, fr = lane & 15, fq = lane >> 4;
  const int K = g.K, nt = K / BK;
  unsigned voffA[2], voffB[2];
#pragma unroll
  for (int i = 0; i < 2; ++i) { int R, C; stage_rc(tid * 16 + i * 8192, R, C);
    voffA[i] = (unsigned)(R * g.lda + C) * 2u; voffB[i] = (unsigned)(R * g.ldb + C) * 2u; }
  asm volatile("" : "+v"(voffA[0]), "+v"(voffA[1]), "+v"(voffB[0]), "+v"(voffB[1]));
  const size_t kstep = (size_t)(BK * 2);
  const size_t hstepA = (size_t)HALF * g.lda * 2, hstepB = (size_t)HALF * g.ldb * 2;
  const size_t tstepA = 2 * hstepA, tstepB = 2 * hstepB;
  const unsigned ldsw = (unsigned)wid * 1024u;
  const int aoff = lds_byte(wr * 64 + fr, fq * 8), boff = lds_byte(wc * 32 + fr, fq * 8);
#define PG8_SA(b, h) (((b) * 2 + (h)) * HTB)
#define PG8_SB(b, h) ((4 + (b) * 2 + (h)) * HTB)
#define PG8_STAGE(bufoff, gbase, voff) do { _Pragma("unroll") for (int _i = 0; _i < 2; ++_i) \
    __builtin_amdgcn_global_load_lds((const unsigned*)((const char*)(gbase) + (voff)[_i]), (LAS unsigned*)(lds + (bufoff) + ldsw + _i * 8192), 16, 0, 0); } while (0)
#define PG8_LDA(dst, b, h) do { _Pragma("unroll") for (int m = 0; m < 4; ++m) _Pragma("unroll") for (int k = 0; k < 2; ++k) dst[m][k] = *(const LAS bf16x8*)(lds + PG8_SA(b, h) + aoff + m * 2048 + k * 1024); } while (0)
#define PG8_LDB(dst, b, h) do { _Pragma("unroll") for (int n = 0; n < 2; ++n) _Pragma("unroll") for (int k = 0; k < 2; ++k) dst[n][k] = *(const LAS bf16x8*)(lds + PG8_SB(b, h) + boff + n * 2048 + k * 1024); } while (0)
#define PG8_MMA(ai, bj, At, Bt) do { __builtin_amdgcn_s_setprio(1); _Pragma("unroll") for (int m = 0; m < 4; ++m) _Pragma("unroll") for (int n = 0; n < 2; ++n) _Pragma("unroll") for (int k = 0; k < 2; ++k) \
    acc[ai][bj][m][n] = __builtin_amdgcn_mfma_f32_16x16x32_bf16(Bt[n][k], At[m][k], acc[ai][bj][m][n], 0, 0, 0); __builtin_amdgcn_s_setprio(0); } while (0)
#define PG8_WAIT_V(n) asm volatile("s_waitcnt vmcnt(" #n ")" ::: "memory")
#define PG8_WAIT_L(n) asm volatile("s_waitcnt lgkmcnt(" #n ")" ::: "memory")
#define PG8_BAR __builtin_amdgcn_s_barrier()
#define PG8_SCHED __builtin_amdgcn_sched_barrier(0)
  Unit cur, nxt; int ui = 0;
  if (!S.next(0, cur)) return;
  f32x4 acc[2][2][4][2];
#pragma unroll
  for (int a = 0; a < 2; ++a)
#pragma unroll
    for (int b = 0; b < 2; ++b)
#pragma unroll
      for (int m = 0; m < 4; ++m)
#pragma unroll
        for (int n = 0; n < 2; ++n) acc[a][b][m][n] = (f32x4){0.f, 0.f, 0.f, 0.f};
  bf16x8 At[4][2], B0[2][2], B1[2][2];
  const char* cA = (const char*)g.A + (size_t)cur.pm * tstepA; const char* cB = (const char*)g.Bt + (size_t)cur.pn * tstepB;
  PG8_STAGE(PG8_SB(0, 0), cB, voffB); PG8_STAGE(PG8_SA(0, 0), cA, voffA); PG8_STAGE(PG8_SB(0, 1), cB + hstepB, voffB); PG8_STAGE(PG8_SA(0, 1), cA + hstepA, voffA);
  if (wr == 1) PG8_BAR;
  PG8_WAIT_V(4); PG8_BAR;
  PG8_STAGE(PG8_SB(1, 0), cB + kstep, voffB); PG8_STAGE(PG8_SA(1, 0), cA + kstep, voffA); PG8_STAGE(PG8_SB(1, 1), cB + hstepB + kstep, voffB);
  PG8_WAIT_V(6); PG8_BAR;
  for (;;) {
    const bool has_next = S.next(ui + 1, nxt);
    const char* nA = has_next ? (const char*)g.A + (size_t)nxt.pm * tstepA : cA; const char* nB = has_next ? (const char*)g.Bt + (size_t)nxt.pn * tstepB : cB;
    for (int t = 0; t < nt; t += 2) {
      const bool last = (t == nt - 2);
      const char* a1 = cA + (size_t)(t + 1) * kstep;
      const char* a2 = last ? nA : cA + (size_t)(t + 2) * kstep; const char* b2 = last ? nB : cB + (size_t)(t + 2) * kstep;
      const char* a3 = a2 + kstep; const char* b3 = b2 + kstep;
      PG8_LDB(B0, 0, 0); PG8_SCHED; PG8_LDA(At, 0, 0); PG8_STAGE(PG8_SA(1, 1), a1 + hstepA, voffA);
      PG8_WAIT_L(8); PG8_BAR; PG8_WAIT_L(0); PG8_MMA(0, 0, At, B0); PG8_BAR; PG8_SCHED;
      PG8_LDB(B1, 0, 1); PG8_STAGE(PG8_SB(0, 0), b2, voffB);
      PG8_BAR; PG8_WAIT_L(0); PG8_MMA(0, 1, At, B1); PG8_BAR;
      PG8_LDA(At, 0, 1); PG8_STAGE(PG8_SA(0, 0), a2, voffA);
      PG8_BAR; PG8_WAIT_L(0); PG8_MMA(1, 0, At, B0); PG8_BAR; PG8_SCHED;
      PG8_STAGE(PG8_SB(0, 1), b2 + hstepB, voffB);
      PG8_WAIT_V(6); PG8_BAR; PG8_MMA(1, 1, At, B1); PG8_BAR;
      PG8_LDB(B0, 1, 0); PG8_SCHED; PG8_LDA(At, 1, 0); PG8_STAGE(PG8_SA(0, 1), a2 + hstepA, voffA);
      PG8_WAIT_L(8); PG8_BAR; PG8_WAIT_L(0); PG8_MMA(0, 0, At, B0); PG8_BAR; PG8_SCHED;
      PG8_LDB(B1, 1, 1); PG8_STAGE(PG8_SB(1, 0), b3, voffB);
      PG8_BAR; PG8_WAIT_L(0); PG8_MMA(0, 1, At, B1); PG8_BAR;
      PG8_LDA(At, 1, 1); PG8_STAGE(PG8_SA(1, 0), a3, voffA);
      PG8_BAR; PG8_WAIT_L(0); PG8_MMA(1, 0, At, B0); PG8_BAR; PG8_SCHED;
      PG8_STAGE(PG8_SB(1, 1), b3 + hstepB, voffB);
      PG8_WAIT_V(6); PG8_BAR; PG8_MMA(1, 1, At, B1); PG8_BAR;
    }
    E(acc, cur, wr, wc, fr, fq);
    if (!has_next) break;
#pragma unroll
    for (int a = 0; a < 2; ++a)
#pragma unroll
      for (int b = 0; b < 2; ++b)
#pragma unroll
        for (int m = 0; m < 4; ++m)
#pragma unroll
          for (int n = 0; n < 2; ++n) acc[a][b][m][n] = (f32x4){0.f, 0.f, 0.f, 0.f};
    cur = nxt; cA = nA; cB = nB; ++ui;
  }
  PG8_WAIT_V(0);
  if (wr == 0) PG8_BAR;
  PG8_BAR;
#undef PG8_SA
#undef PG8_SB
#undef PG8_STAGE
#undef PG8_LDA
#undef PG8_LDB
#undef PG8_MMA
#undef PG8_WAIT_V
#undef PG8_WAIT_L
#undef PG8_BAR
#undef PG8_SCHED
}


template <class Epi>
__device__ __forceinline__ void gemm_phase_seg(LAS unsigned char* lds, const bf16_t* A0, const bf16_t* A1, const bf16_t* A2,
                                               const bf16_t* Bt0, const bf16_t* Bt1, const bf16_t* Bt2, int K0, int K12, const StaticOrder& S, const Epi& E) {
  int tid = threadIdx.x; asm volatile("" : "+v"(tid));
  const int wid = __builtin_amdgcn_readfirstlane(tid >> 6), lane = tid & 63, wr = wid >> 2, wc = wid & 3, fr = lane & 15, fq = lane >> 4;
  unsigned Rv[2], C2[2];
#pragma unroll
  for (int i = 0; i < 2; ++i) { int R, C; stage_rc(tid * 16 + i * 8192, R, C); Rv[i] = (unsigned)R; C2[i] = (unsigned)C * 2u; }
  asm volatile("" : "+v"(Rv[0]), "+v"(Rv[1]), "+v"(C2[0]), "+v"(C2[1]));
  const size_t kstep = (size_t)(BK * 2);
  const unsigned ldsw = (unsigned)wid * 1024u;
  const int aoff = lds_byte(wr * 64 + fr, fq * 8), boff = lds_byte(wc * 32 + fr, fq * 8);
#define PG8_SA(b, h) (((b) * 2 + (h)) * HTB)
#define PG8_SB(b, h) ((4 + (b) * 2 + (h)) * HTB)
#define PG8_STAGE(bufoff, gbase, ld2) do { _Pragma("unroll") for (int _i = 0; _i < 2; ++_i) \
    __builtin_amdgcn_global_load_lds((const unsigned*)((const char*)(gbase) + (Rv[_i] * (unsigned)(ld2) + C2[_i])), (LAS unsigned*)(lds + (bufoff) + ldsw + _i * 8192), 16, 0, 0); } while (0)
#define PG8_LDA(dst, b, h) do { _Pragma("unroll") for (int m = 0; m < 4; ++m) _Pragma("unroll") for (int k = 0; k < 2; ++k) dst[m][k] = *(const LAS bf16x8*)(lds + PG8_SA(b, h) + aoff + m * 2048 + k * 1024); } while (0)
#define PG8_LDB(dst, b, h) do { _Pragma("unroll") for (int n = 0; n < 2; ++n) _Pragma("unroll") for (int k = 0; k < 2; ++k) dst[n][k] = *(const LAS bf16x8*)(lds + PG8_SB(b, h) + boff + n * 2048 + k * 1024); } while (0)
#define PG8_MMA(ai, bj, At, Bt) do { __builtin_amdgcn_s_setprio(1); _Pragma("unroll") for (int m = 0; m < 4; ++m) _Pragma("unroll") for (int n = 0; n < 2; ++n) _Pragma("unroll") for (int k = 0; k < 2; ++k) \
    acc[ai][bj][m][n] = __builtin_amdgcn_mfma_f32_16x16x32_bf16(Bt[n][k], At[m][k], acc[ai][bj][m][n], 0, 0, 0); __builtin_amdgcn_s_setprio(0); } while (0)
#define PG8_WAIT_V(n) asm volatile("s_waitcnt vmcnt(" #n ")" ::: "memory")
#define PG8_WAIT_L(n) asm volatile("s_waitcnt lgkmcnt(" #n ")" ::: "memory")
#define PG8_BAR __builtin_amdgcn_s_barrier()
#define PG8_SCHED __builtin_amdgcn_sched_barrier(0)
  Unit cur, nxt; int ui = 0; int cseg = 0;
  if (!S.next(0, cur)) return;
  f32x4 acc[2][2][4][2];
#pragma unroll
  for (int a = 0; a < 2; ++a)
#pragma unroll
    for (int b = 0; b < 2; ++b)
#pragma unroll
      for (int m = 0; m < 4; ++m)
#pragma unroll
        for (int n = 0; n < 2; ++n) acc[a][b][m][n] = (f32x4){0.f, 0.f, 0.f, 0.f};
  bf16x8 At[4][2], B0[2][2], B1[2][2];
  int cK = K0;
  unsigned ld2 = (unsigned)cK * 2u;
  size_t hstep = (size_t)HALF * ld2;
  const char* cA = (const char*)A0 + (size_t)cur.pm * 2 * hstep; const char* cB = (const char*)Bt0 + (size_t)cur.pn * 2 * hstep;
  PG8_STAGE(PG8_SB(0, 0), cB, ld2); PG8_STAGE(PG8_SA(0, 0), cA, ld2); PG8_STAGE(PG8_SB(0, 1), cB + hstep, ld2); PG8_STAGE(PG8_SA(0, 1), cA + hstep, ld2);
  if (wr == 1) PG8_BAR;
  PG8_WAIT_V(4); PG8_BAR;
  PG8_STAGE(PG8_SB(1, 0), cB + kstep, ld2); PG8_STAGE(PG8_SA(1, 0), cA + kstep, ld2); PG8_STAGE(PG8_SB(1, 1), cB + hstep + kstep, ld2);
  PG8_WAIT_V(6); PG8_BAR;
  for (;;) {
    int nseg = cseg + 1; bool has_next = true; nxt = cur;
    if (nseg == 3) { nseg = 0; has_next = S.next(ui + 1, nxt); }
    const int nK = has_next ? (nseg == 0 ? K0 : K12) : cK;
    const unsigned nld2 = (unsigned)nK * 2u;
    const size_t nhstep = (size_t)HALF * nld2;
    const bf16_t* nAb = nseg == 0 ? A0 : (nseg == 1 ? A1 : A2);
    const bf16_t* nBb = nseg == 0 ? Bt0 : (nseg == 1 ? Bt1 : Bt2);
    const char* nA = has_next ? (const char*)nAb + (size_t)nxt.pm * 2 * nhstep : cA;
    const char* nB = has_next ? (const char*)nBb + (size_t)nxt.pn * 2 * nhstep : cB;
    const int nt = cK / BK;
    for (int t = 0; t < nt; t += 2) {
      const bool last = (t == nt - 2);
      const char* a1 = cA + (size_t)(t + 1) * kstep;
      const char* a2 = last ? nA : cA + (size_t)(t + 2) * kstep; const char* b2 = last ? nB : cB + (size_t)(t + 2) * kstep;
      const char* a3 = a2 + kstep; const char* b3 = b2 + kstep;
      const unsigned l2 = last ? nld2 : ld2; const size_t h2 = last ? nhstep : hstep;
      PG8_LDB(B0, 0, 0); PG8_SCHED; PG8_LDA(At, 0, 0); PG8_STAGE(PG8_SA(1, 1), a1 + hstep, ld2);
      PG8_WAIT_L(8); PG8_BAR; PG8_WAIT_L(0); PG8_MMA(0, 0, At, B0); PG8_BAR; PG8_SCHED;
      PG8_LDB(B1, 0, 1); PG8_STAGE(PG8_SB(0, 0), b2, l2);
      PG8_BAR; PG8_WAIT_L(0); PG8_MMA(0, 1, At, B1); PG8_BAR;
      PG8_LDA(At, 0, 1); PG8_STAGE(PG8_SA(0, 0), a2, l2);
      PG8_BAR; PG8_WAIT_L(0); PG8_MMA(1, 0, At, B0); PG8_BAR; PG8_SCHED;
      PG8_STAGE(PG8_SB(0, 1), b2 + h2, l2);
      PG8_WAIT_V(6); PG8_BAR; PG8_MMA(1, 1, At, B1); PG8_BAR;
      PG8_LDB(B0, 1, 0); PG8_SCHED; PG8_LDA(At, 1, 0); PG8_STAGE(PG8_SA(0, 1), a2 + h2, l2);
      PG8_WAIT_L(8); PG8_BAR; PG8_WAIT_L(0); PG8_MMA(0, 0, At, B0); PG8_BAR; PG8_SCHED;
      PG8_LDB(B1, 1, 1); PG8_STAGE(PG8_SB(1, 0), b3, l2);
      PG8_BAR; PG8_WAIT_L(0); PG8_MMA(0, 1, At, B1); PG8_BAR;
      PG8_LDA(At, 1, 1); PG8_STAGE(PG8_SA(1, 0), a3, l2);
      PG8_BAR; PG8_WAIT_L(0); PG8_MMA(1, 0, At, B0); PG8_BAR; PG8_SCHED;
      PG8_STAGE(PG8_SB(1, 1), b3 + h2, l2);
      PG8_WAIT_V(6); PG8_BAR; PG8_MMA(1, 1, At, B1); PG8_BAR;
    }
    E(acc, cur, cseg, wr, wc, fr, fq);
    if (!has_next) break;
    if (nseg == 0) {
#pragma unroll
      for (int a = 0; a < 2; ++a)
#pragma unroll
        for (int b = 0; b < 2; ++b)
#pragma unroll
          for (int m = 0; m < 4; ++m)
#pragma unroll
            for (int n = 0; n < 2; ++n) acc[a][b][m][n] = (f32x4){0.f, 0.f, 0.f, 0.f};
      ++ui;
    }
    cur = nxt; cA = nA; cB = nB; cseg = nseg; cK = nK; ld2 = nld2; hstep = nhstep;
  }
  PG8_WAIT_V(0);
  if (wr == 0) PG8_BAR;
  PG8_BAR;
#undef PG8_SA
#undef PG8_SB
#undef PG8_STAGE
#undef PG8_LDA
#undef PG8_LDB
#undef PG8_MMA
#undef PG8_WAIT_V
#undef PG8_WAIT_L
#undef PG8_BAR
#undef PG8_SCHED
}

template <class FL, class FA> struct EpiSeg {
  FL ld; FA ap;
  __device__ __forceinline__ void operator()(f32x4 (&acc)[2][2][4][2], const Unit& u, int seg, int wr, int wc, int fr, int fq) const {
    asm volatile("" : "+v"(fr), "+v"(fq));
    uint2 g[2][4][2][2];
#pragma unroll
    for (int ai = 0; ai < 2; ++ai)
#pragma unroll
      for (int m = 0; m < 4; ++m) {
        const int row = u.pm * BM + ai * HALF + wr * 64 + m * 16 + fr;
#pragma unroll
        for (int bj = 0; bj < 2; ++bj)
#pragma unroll
          for (int n = 0; n < 2; ++n) g[ai][m][bj][n] = ld(row, u.pn * BM + bj * HALF + wc * 32 + n * 16 + 4 * fq, seg);
      }
#pragma unroll
    for (int ai = 0; ai < 2; ++ai)
#pragma unroll
      for (int m = 0; m < 4; ++m) {
        const int row = u.pm * BM + ai * HALF + wr * 64 + m * 16 + fr;
#pragma unroll
        for (int bj = 0; bj < 2; ++bj)
#pragma unroll
          for (int n = 0; n < 2; ++n) ap(row, u.pn * BM + bj * HALF + wc * 32 + n * 16 + 4 * fq, acc[ai][bj][m][n], seg, g[ai][m][bj][n]);
      }
  }
};
template <class FL, class FA> __device__ __forceinline__ EpiSeg<FL, FA> make_epi_seg(FL l, FA a) { return EpiSeg<FL, FA>{l, a}; }

template <class F> struct EpiL {
  F f;
  __device__ __forceinline__ void operator()(const f32x4 (&acc)[2][2][4][2], const Unit& u, int wr, int wc, int fr, int fq) const {
    asm volatile("" : "+v"(fr), "+v"(fq));
#pragma unroll
    for (int ai = 0; ai < 2; ++ai)
#pragma unroll
      for (int m = 0; m < 4; ++m) {
        const int row = u.pm * BM + ai * HALF + wr * 64 + m * 16 + fr;
#pragma unroll
        for (int bj = 0; bj < 2; ++bj)
#pragma unroll
          for (int n = 0; n < 2; ++n) f(row, u.pn * BM + bj * HALF + wc * 32 + n * 16 + 4 * fq, acc[ai][bj][m][n]);
        asm volatile("" ::: "memory");
      }
  }
};
template <class F> __device__ __forceinline__ EpiL<F> make_epi(F f) { return EpiL<F>{f}; }
}

template <class F>
__device__ __forceinline__ void run_gemm(LAS unsigned char* lds, const bf16_t* A, int lda, const bf16_t* Bt, int ldb, int N, int K, F f, int boff = 0) {
  asm volatile("" : "+s"(K), "+s"(lda), "+s"(ldb));
  pg8::StaticOrder S; S.init(16384, N, gridDim.x, (int)((blockIdx.x + (unsigned)boff) % gridDim.x));
  pg8::Gemm g{A, Bt, lda, ldb, K};
  pg8::gemm_phase(lds, g, S, pg8::make_epi(f));
}

__device__ __forceinline__ void transpose_tile(const float* __restrict__ src, int lds_, bf16_t* __restrict__ dst, int ldd, float* tile, int tid) {
#pragma unroll
  for (int i = 0; i < 2; ++i) {
    int idx = tid + i * 512;
    int r = idx >> 4, c4 = (idx & 15) * 4;
    float4 v = ld_nt4(src + (size_t)r * lds_ + c4);
    *(float4*)(tile + r * 68 + c4) = v;
  }
  __syncthreads();
  {
    int n = tid & 63, k0 = (tid >> 6) * 8;
    const float* tp = tile + k0 * 68 + n;
    uint4 o;
    o.x = pack2(tp[0], tp[68]); o.y = pack2(tp[136], tp[204]); o.z = pack2(tp[272], tp[340]); o.w = pack2(tp[408], tp[476]);
    *(uint4*)(dst + (size_t)n * ldd + k0) = o;
  }
  __syncthreads();
}

__device__ __forceinline__ void convert_layer(const Params& p, int l, float* tile, int tid) {
  asm volatile("" : "+v"(tid));
  bf16_t* WT = (bf16_t*)(p.ws + WS_WT);
  bf16_t* VCT = (bf16_t*)(p.ws + WS_UB + UB_VCT);
  bf16_t* KC = (bf16_t*)(p.ws + WS_UB + UB_KC);
  for (int ti0 = blockIdx.x; ti0 < 4496; ti0 += gridDim.x) {
    int ti = ti0;
    const float* src; int lds_; bf16_t* dst; int ldd;
    if (ti < 1344) {
      int kt = ti / 84, nt = ti % 84;
      src = p.w_in + (size_t)l * 1024 * 5376 + (size_t)kt * 64 * 5376 + nt * 64; lds_ = 5376;
      int nrow = nt * 64; nrow = nrow < 2048 ? nrow : (nrow < 2304 ? nrow + 3072 : nrow - 256);
      dst = WT + WT_IN + (size_t)nrow * 1024 + kt * 64; ldd = 1024;
    } else if ((ti -= 1344) < 128) {
      int kt = ti / 16, nt = ti % 16;
      src = p.w_br_attn + (size_t)l * 512 * 1024 + (size_t)kt * 64 * 1024 + nt * 64; lds_ = 1024;
      dst = WT + WT_BRA + (size_t)nt * 64 * 512 + kt * 64; ldd = 512;
    } else if ((ti -= 128) < 64) {
      int kt = ti / 16, nt = ti % 16;
      src = p.w_br_s5 + (size_t)l * 256 * 1024 + (size_t)kt * 64 * 1024 + nt * 64; lds_ = 1024;
      dst = WT + WT_BRS + (size_t)nt * 64 * 256 + kt * 64; ldd = 256;
    } else if ((ti -= 64) < 64) {
      int kt = ti / 16, nt = ti % 16;
      src = p.w_br_lru + (size_t)l * 256 * 1024 + (size_t)kt * 64 * 1024 + nt * 64; lds_ = 1024;
      dst = WT + WT_BRL + (size_t)nt * 64 * 256 + kt * 64; ldd = 256;
    } else if ((ti -= 64) < 256) {
      int kt = ti / 16, nt = ti % 16;
      src = p.w_out + (size_t)l * 1024 * 1024 + (size_t)kt * 64 * 1024 + nt * 64; lds_ = 1024;
      dst = WT + WT_OUT + (size_t)nt * 64 * 1024 + kt * 64; ldd = 1024;
    } else if ((ti -= 256) < 1408) {
      int kt = ti / 88, nt = ti % 88;
      src = p.ffn_w_up + (size_t)l * 1024 * 5632 + (size_t)kt * 64 * 5632 + nt * 64; lds_ = 5632;
      dst = WT + WT_UP + (size_t)nt * 64 * 1024 + kt * 64; ldd = 1024;
    } else if ((ti -= 1408) < 704) {
      int kt = ti / 16, nt = ti % 16;
      src = p.ffn_w_down + (size_t)l * 2816 * 1024 + (size_t)kt * 64 * 1024 + nt * 64; lds_ = 1024;
      dst = WT + WT_DOWN + (size_t)nt * 64 * 2816 + kt * 64; ldd = 2816;
    } else if ((ti -= 704) < 16) {
      int kt = ti / 4, nt = ti % 4;
      src = p.s5_w_glu + (size_t)l * 65536 + (size_t)kt * 64 * 256 + nt * 64; lds_ = 256;
      dst = WT + WT_GLU + (size_t)nt * 64 * 256 + kt * 64; ldd = 256;
    } else {
      ti -= 16;
      int ct = ti & 7, h = (ti >> 3) & 7, b = ti >> 6;
      src = p.cache_v + ((size_t)(b * 2 + l) * 512 + ct * 64) * 512 + h * 64; lds_ = 512;
      dst = VCT + (size_t)((b * 8 + h) * 64) * 512 + ct * 64; ldd = 512;
    }
    transpose_tile(src, lds_, dst, ldd, tile, tid);
  }
  for (int idx = blockIdx.x * 512 + tid; idx < 262144; idx += gridDim.x * 512) {
    int d8 = idx & 7, h = (idx >> 3) & 7, c = (idx >> 6) & 511, b = idx >> 15;
    const float* s = p.cache_k + ((size_t)((b * 2 + l) * 512 + c) * 8 + h) * 64 + d8 * 8;
    float4 v0 = ld_nt4(s), v1 = ld_nt4(s + 4);
    uint4 o;
    o.x = pack2(v0.x, v0.y); o.y = pack2(v0.z, v0.w); o.z = pack2(v1.x, v1.y); o.w = pack2(v1.z, v1.w);
    *(uint4*)(KC + ((size_t)((b * 8 + h) * 512 + c)) * 64 + d8 * 8) = o;
  }
  for (int idx = blockIdx.x * 512 + tid; idx < 262144; idx += gridDim.x * 512) {
    int n = idx >> 8, k = idx & 255;
    int dir = n >> 9, gate = (n >> 8) & 1, ch = n & 255;
    int blk = ch >> 6, j = ch & 63, kb = k >> 6, i = k & 63;
    float v = 0.f;
    if (kb == blk) v = (gate ? p.lru_w_x : p.lru_w_a)[(size_t)l * 32768 + ((size_t)(dir * 4 + blk) * 64 + i) * 64 + j];
    WT[WT_LRU + idx] = f2bf(v);
  }
}

__device__ __forceinline__ void norm_phase(const Params& p, int l, int which, bool from_inputs, int tid) {
  float* X = p.out;
  const float* MOD = (const float*)(p.ws + WS_MOD) + (size_t)l * 9 * 6144;
  bf16_t* H = (bf16_t*)(p.ws + WS_HBUF);
  const float* g = (which == 0 ? p.g1 : p.g2) + l * 1024;
  const int shoff = which == 0 ? 0 : 3072, scoff = which == 0 ? 1024 : 4096;
  asm volatile("" : "+v"(tid));
  const int lane = tid & 63, wave = tid >> 6;
  for (int r = blockIdx.x * 8 + wave; r < 16384; r += gridDim.x * 8) {
    const float* xr = from_inputs ? (r < 8192 ? p.x_prompt + (size_t)r * 1024 : p.x_sample + (size_t)(r - 8192) * 1024)
                                  : X + (size_t)r * 1024;
    float4 v[4];
    float ss = 0.f;
#pragma unroll
    for (int i = 0; i < 4; ++i) {
      v[i] = *(const float4*)(xr + i * 256 + lane * 4);
      ss += v[i].x * v[i].x + v[i].y * v[i].y + v[i].z * v[i].z + v[i].w * v[i].w;
    }
#pragma unroll
    for (int o = 32; o >= 1; o >>= 1) ss += __shfl_xor(ss, o);
    float rstd = rsqrtf(ss * (1.f / 1024.f) + 1e-6f);
    const float* mr = MOD + (size_t)modrow(r) * 6144;
#pragma unroll
    for (int i = 0; i < 4; ++i) {
      int c = i * 256 + lane * 4;
      float4 gg = *(const float4*)(g + c);
      float4 sc = *(const float4*)(mr + scoff + c);
      float4 sh = *(const float4*)(mr + shoff + c);
      float o0 = v[i].x * rstd * gg.x * (1.f + sc.x) + sh.x;
      float o1 = v[i].y * rstd * gg.y * (1.f + sc.y) + sh.y;
      float o2 = v[i].z * rstd * gg.z * (1.f + sc.z) + sh.z;
      float o3 = v[i].w * rstd * gg.w * (1.f + sc.w) + sh.w;
      uint2 o; o.x = pack2(o0, o1); o.y = pack2(o2, o3);
      *(uint2*)(H + (size_t)r * 1024 + c) = o;
    }
  }
}

struct AttnState {
  f32x4 o[4];
  float m, lsum;
};

__device__ __forceinline__ void attn_scores(const bf16_t* kb, int kld, const bf16x8 (&qf)[2], float (&s)[8], int l15, int quad) {
#pragma unroll
  for (int half = 0; half < 2; ++half) {
    const bf16_t* kp = kb + (size_t)(half * 16 + l15) * kld + quad * 8;
    bf16x8 a0 = *(const bf16x8*)kp;
    bf16x8 a1 = *(const bf16x8*)(kp + 32);
    f32x4 acc = {0.f, 0.f, 0.f, 0.f};
    acc = __builtin_amdgcn_mfma_f32_16x16x32_bf16(a0, qf[0], acc, 0, 0, 0);
    acc = __builtin_amdgcn_mfma_f32_16x16x32_bf16(a1, qf[1], acc, 0, 0, 0);
#pragma unroll
    for (int e = 0; e < 4; ++e) s[half * 4 + e] = acc[e];
  }
}

__device__ __forceinline__ void attn_update(AttnState& st, float (&s)[8], const bf16_t* vt, int vtld, int l15, int quad) {
  float tm = s[0];
#pragma unroll
  for (int i = 1; i < 8; ++i) tm = fmaxf(tm, s[i]);
  tm = fmaxf(tm, __shfl_xor(tm, 16));
  tm = fmaxf(tm, __shfl_xor(tm, 32));
  float mn = fmaxf(st.m, tm);
  float alpha = __expf(st.m - mn);
  st.m = mn;
  float pv[8];
  float ps = 0.f;
#pragma unroll
  for (int i = 0; i < 8; ++i) { pv[i] = __expf(s[i] - mn); ps += pv[i]; }
  st.lsum = st.lsum * alpha + ps;
  union { uint4 u; bf16x8 v; } pb;
  pb.u.x = pack2(pv[0], pv[1]); pb.u.y = pack2(pv[2], pv[3]); pb.u.z = pack2(pv[4], pv[5]); pb.u.w = pack2(pv[6], pv[7]);
#pragma unroll
  for (int db = 0; db < 4; ++db) {
    const bf16_t* vp = vt + (size_t)(db * 16 + l15) * vtld + quad * 4;
    uint2 lo = *(const uint2*)vp;
    uint2 hi = *(const uint2*)(vp + 16);
    union { uint4 u; bf16x8 v; } va;
    va.u.x = lo.x; va.u.y = lo.y; va.u.z = hi.x; va.u.w = hi.y;
    f32x4 o = st.o[db];
    o[0] *= alpha; o[1] *= alpha; o[2] *= alpha; o[3] *= alpha;
    st.o[db] = __builtin_amdgcn_mfma_f32_16x16x32_bf16(va.v, pb.v, o, 0, 0, 0);
  }
}

__device__ __forceinline__ void s5_disc(const Params& p, int l, int dir, int g, int n, float& lbr, float& lbi, float& cr, float& ci) {
  int li = ((l * 2 + dir) * 16 + g) * 64 + n;
  float lre = p.s5_lam_re[li], lim = p.s5_lam_im[li];
  float stp = expf(p.s5_log_step[(l * 2 + dir) * 16 + g]);
  float er = expf(lre * stp);
  float ang = lim * stp;
  lbr = er * cosf(ang); lbi = er * sinf(ang);
  float nr = lbr - 1.f, ni = lbi;
  float den = lre * lre + lim * lim;
  cr = (nr * lre + ni * lim) / den;
  ci = (ni * lre - nr * lim) / den;
}

#define S5_BUS 132
#define S5_HS 136
#define S5_WAVE_BYTES 12800

__global__ void __launch_bounds__(512, 2) mega(Params p) {
  cg::grid_group grid = cg::this_grid();
  extern __shared__ __attribute__((aligned(16))) unsigned char dyn_lds[];
  LAS unsigned char* lds = (LAS unsigned char*)dyn_lds;
  char* smem_raw = (char*)dyn_lds;
  const int tid = threadIdx.x;
  const int lane = tid & 63, wave = tid >> 6;
  const int l15 = lane & 15, quad = lane >> 4;

  volatile LAS unsigned* xb_st = (volatile LAS unsigned*)(lds + 132096);
  if (tid == 0) { xb_st[0] = 0u; xb_st[1] = 0u; }
  __syncthreads();
  unsigned* const BAR = (unsigned*)(p.ws + WS_BAR);
  const XcdBarrier xb = xcd_barrier_post(BAR, xb_st);

  char* const WSB = p.ws;
  float* const OUTB = p.out;
#define X OUTB
#define MODALL ((float*)(WSB + WS_MOD))
#define WT ((bf16_t*)(WSB + WS_WT))
#define HBUF ((bf16_t*)(WSB + WS_HBUF))
#define UB (WSB + WS_UB)
#define QB ((bf16_t*)(WSB + WS_UB + UB_QB))
#define KB ((bf16_t*)(WSB + WS_UB + UB_KB))
#define VTC ((bf16_t*)(WSB + WS_UB + UB_VTC))
#define VTL ((bf16_t*)(WSB + WS_UB + UB_VTL))
#define U ((bf16_t*)(WSB + WS_UB + UB_U))
#define XR ((bf16_t*)(WSB + WS_UB + UB_XR))
#define XG ((bf16_t*)(WSB + WS_UB + UB_XG))
#define S5Y ((bf16_t*)(WSB + WS_UB + UB_S5Y))
#define LRUY ((bf16_t*)(WSB + WS_UB + UB_LRUY))
#define MG ((bf16_t*)(WSB + WS_UB + UB_MG))
#define KC ((bf16_t*)(WSB + WS_UB + UB_KC))
#define VCT ((bf16_t*)(WSB + WS_UB + UB_VCT))
#define G8 ((unsigned char*)(WSB + WS_UB + UB_G8))

  {
    float* sc = (float*)smem_raw;
    float* red = sc + 9 * 1024;
    if (blockIdx.x < 384) {
      for (int i = tid; i < 9 * 1024; i += 512) {
        int m = i >> 10, k = i & 1023;
        float v = (m == 0) ? p.c_ctx[k] : p.c[(m - 1) * 1024 + k];
        sc[i] = v / (1.f + __expf(-v));
      }
      __syncthreads();
      for (int item = blockIdx.x; item < 384; item += gridDim.x) {
        int l = item / 192, n0 = (item % 192) * 32;
        int cs_ = tid & 31, ks = tid >> 5;
        float a0 = 0, a1 = 0, a2 = 0, a3 = 0, a4 = 0, a5 = 0, a6 = 0, a7 = 0, a8 = 0;
        const float* w = p.w_ada + (size_t)l * 1024 * 6144 + (size_t)(ks * 64) * 6144 + n0 + cs_;
        const float* s0 = sc + ks * 64;
#pragma unroll 8
        for (int k = 0; k < 64; ++k) {
          float wv = __builtin_nontemporal_load(w + (size_t)k * 6144);
          a0 += s0[k] * wv; a1 += s0[1024 + k] * wv; a2 += s0[2048 + k] * wv; a3 += s0[3072 + k] * wv;
          a4 += s0[4096 + k] * wv; a5 += s0[5120 + k] * wv; a6 += s0[6144 + k] * wv; a7 += s0[7168 + k] * wv;
          a8 += s0[8192 + k] * wv;
        }
        red[(ks * 9 + 0) * 32 + cs_] = a0; red[(ks * 9 + 1) * 32 + cs_] = a1; red[(ks * 9 + 2) * 32 + cs_] = a2;
        red[(ks * 9 + 3) * 32 + cs_] = a3; red[(ks * 9 + 4) * 32 + cs_] = a4; red[(ks * 9 + 5) * 32 + cs_] = a5;
        red[(ks * 9 + 6) * 32 + cs_] = a6; red[(ks * 9 + 7) * 32 + cs_] = a7; red[(ks * 9 + 8) * 32 + cs_] = a8;
        __syncthreads();
        if (tid < 288) {
          int m = tid >> 5, c = tid & 31;
          float s = 0.f;
#pragma unroll
          for (int k2 = 0; k2 < 16; ++k2) s += red[(k2 * 9 + m) * 32 + c];
          MODALL[(size_t)(l * 9 + m) * 6144 + n0 + c] = s + p.b_ada[l * 6144 + n0 + c];
        }
        __syncthreads();
      }
    }
    __syncthreads();
    PH(11) convert_layer(p, 0, (float*)smem_raw, tid);
  }
  grid.sync();

  for (int l = 0; l < 2; ++l) {
    const float* MOD = MODALL + (size_t)l * 9 * 6144;
    if (l == 1) PH(11) convert_layer(p, 1, (float*)smem_raw, tid);
    PH(12) norm_phase(p, l, 0, l == 0, tid);
    GSYNC();

    float* const OUTP = p.out;
    PH(1) run_gemm(lds, HBUF, 1024, WT + WT_IN, 1024, 5120, 1024, [=](int row, int col, f32x4 v) {
      if (col < 512) {
        const float qs = 0.125f * 1.4426950408889634f;
        uint2 o; o.x = pack2(v[0] * qs, v[1] * qs); o.y = pack2(v[2] * qs, v[3] * qs);
        *(uint2*)(QB + (size_t)row * 512 + col) = o;
      } else if (col < 1024) {
        uint2 o; o.x = pack2(v[0], v[1]); o.y = pack2(v[2], v[3]);
        *(uint2*)(KB + (size_t)row * 512 + col - 512) = o;
        if (row < 8192) {
          int b = row >> 8, t = row & 255;
          *(f32x4*)(OUTP + OUT_NEWK + ((size_t)((b * 2 + l) * 256 + t)) * 512 + (col - 512)) = v;
        }
      } else if (col < 1536) {
        int c = col - 1024, h = c >> 6, d = c & 63;
        if (row < 8192) {
          int b = row >> 8, t = row & 255;
          bf16_t* vp = VTC + ((size_t)((b * 8 + h) * 64 + d)) * 256 + t;
          vp[0] = f2bf(v[0]); vp[256] = f2bf(v[1]); vp[512] = f2bf(v[2]); vp[768] = f2bf(v[3]);
          *(f32x4*)(OUTP + OUT_NEWV + ((size_t)((b * 2 + l) * 256 + t)) * 512 + c) = v;
        } else {
          int b = (row - 8192) >> 10, t = (row - 8192) & 1023;
          bf16_t* vp = VTL + ((size_t)((b * 8 + h) * 64 + d)) * 1024 + t;
          vp[0] = f2bf(v[0]); vp[1024] = f2bf(v[1]); vp[2048] = f2bf(v[2]); vp[3072] = f2bf(v[3]);
        }
      } else if (col < 2048) {
        uint2 o; o.x = pack2(v[0], v[1]); o.y = pack2(v[2], v[3]);
        bf16_t* dst = col < 1792 ? U + (size_t)row * 256 + (col - 1536) : XR + (size_t)row * 256 + (col - 1792);
        *(uint2*)dst = o;
      } else {
        uint32_t q0 = (uint32_t)(sigmoidf_(v[0]) * 255.f + 0.5f), q1 = (uint32_t)(sigmoidf_(v[1]) * 255.f + 0.5f);
        uint32_t q2 = (uint32_t)(sigmoidf_(v[2]) * 255.f + 0.5f), q3 = (uint32_t)(sigmoidf_(v[3]) * 255.f + 0.5f);
        *(uint32_t*)(G8 + (size_t)row * 3072 + (col - 2048)) = q0 | (q1 << 8) | (q2 << 16) | (q3 << 24);
      }
    });
    GSYNC();

    PH(15) run_gemm(lds, HBUF, 1024, WT + WT_IN + (size_t)5120 * 1024, 1024, 256, 1024, [=](int row, int col, f32x4 v) {
      uint2 o; o.x = pack2(v[0], v[1]); o.y = pack2(v[2], v[3]);
      *(uint2*)(XG + (size_t)row * 256 + col) = o;
    }, 64);
    PH(2) for (;;) {
      LAUNDER_TID();
      if (tid == 0) xb_st[2] = xb_add(&BAR[XB_WQ(l * 2 + 0)], 1u);
      __syncthreads();
      const int item0 = (int)xb_st[2];
      __syncthreads();
      if (item0 >= 800 * (((REP_MASK >> 2) & 1) + 1)) break;
      int item = item0 % 800;
      int kind, sub;
      if (item < 32) { kind = 0; sub = 128 + item; }
      else if (item < 288) { kind = 1; sub = item - 32; }
      else if (item < 416) { kind = 0; sub = item - 288; }
      else if (item < 672) { kind = 2; sub = item - 416; }
      else { kind = 3; sub = item - 672; }
      if (kind == 0) {
        int s = sub >> 2, gq = sub & 3;
        int g = gq * 4 + (wave >> 1), dir = wave & 1;
        int L = s < 32 ? 256 : 1024;
        int row0 = s < 32 ? s * 256 : 8192 + (s - 32) * 1024;
        float* BUs = (float*)(smem_raw + wave * S5_WAVE_BYTES);
        bf16_t* Hs = (bf16_t*)(smem_raw + wave * S5_WAVE_BYTES + 8448);
        float lbr, lbi;
        {
          float cr, ci;
          s5_disc(p, l, dir, g, lane, lbr, lbi, cr, ci);
        }
        bf16x8 bfrag[8];
#pragma unroll
        for (int nb = 0; nb < 4; ++nb) {
          int n2 = nb * 16 + l15;
          float t0, t1, cr, ci;
          s5_disc(p, l, dir, g, n2, t0, t1, cr, ci);
          union { uint4 u; bf16x8 v; } fr_, fi_;
          fr_.u = make_uint4(0, 0, 0, 0); fi_.u = make_uint4(0, 0, 0, 0);
          if (quad < 2) {
            const float* br = p.s5_b_re + ((size_t)(l * 16 + g) * 64 + n2) * 16 + quad * 8;
            const float* bi = p.s5_b_im + ((size_t)(l * 16 + g) * 64 + n2) * 16 + quad * 8;
            float4 r0 = *(const float4*)br, r1 = *(const float4*)(br + 4);
            float4 i0 = *(const float4*)bi, i1 = *(const float4*)(bi + 4);
            fr_.u.x = pack2(cr * r0.x - ci * i0.x, cr * r0.y - ci * i0.y);
            fr_.u.y = pack2(cr * r0.z - ci * i0.z, cr * r0.w - ci * i0.w);
            fr_.u.z = pack2(cr * r1.x - ci * i1.x, cr * r1.y - ci * i1.y);
            fr_.u.w = pack2(cr * r1.z - ci * i1.z, cr * r1.w - ci * i1.w);
            fi_.u.x = pack2(cr * i0.x + ci * r0.x, cr * i0.y + ci * r0.y);
            fi_.u.y = pack2(cr * i0.z + ci * r0.z, cr * i0.w + ci * r0.w);
            fi_.u.z = pack2(cr * i1.x + ci * r1.x, cr * i1.y + ci * r1.y);
            fi_.u.w = pack2(cr * i1.z + ci * r1.z, cr * i1.w + ci * r1.w);
          }
          bfrag[nb] = fr_.v; bfrag[4 + nb] = fi_.v;
        }
        bf16x8 cfrag[4];
#pragma unroll
        for (int ks = 0; ks < 4; ++ks) {
          const float* cp = (ks < 2 ? p.s5_c_re : p.s5_c_im) + (size_t)((l * 2 + dir) * 16 + g) * 1024 + l15 * 64 + (ks & 1) * 32 + quad * 8;
          float sg = ks < 2 ? 1.f : -1.f;
          float4 c0 = *(const float4*)cp, c1 = *(const float4*)(cp + 4);
          union { uint4 u; bf16x8 v; } cf;
          cf.u.x = pack2(sg * c0.x, sg * c0.y); cf.u.y = pack2(sg * c0.z, sg * c0.w);
          cf.u.z = pack2(sg * c1.x, sg * c1.y); cf.u.w = pack2(sg * c1.z, sg * c1.w);
          cfrag[ks] = cf.v;
        }
        float hr = 0.f, hi = 0.f;
        if (s >= 32) {
          int si = ((((s - 32) * 2 + l) * 2 + dir) * 16 + g) * 64 + lane;
          hr = p.st_s5_re[si]; hi = p.st_s5_im[si];
        }
        bf16_t* ydst = dir == 0 ? S5Y : MG;
        __syncthreads();
        auto load_u = [&](int kb) -> uint4 {
          uint4 r = make_uint4(0, 0, 0, 0);
          int k = kb * 16 + l15;
          int t = dir ? (L - 1 - k) : k;
          if (quad < 2) r = *(const uint4*)(U + (size_t)(row0 + t) * 256 + g * 16 + quad * 8);
          return r;
        };
        uint4 ucur = load_u(0);
        const int nkb = L / 16;
        for (int kb = 0; kb < nkb; ++kb) {
          uint4 unext = make_uint4(0, 0, 0, 0);
          if (kb + 1 < nkb) unext = load_u(kb + 1);
          union { uint4 u; bf16x8 v; } uf;
          uf.u = ucur;
#pragma unroll
          for (int cb = 0; cb < 8; ++cb) {
            f32x4 a = {0.f, 0.f, 0.f, 0.f};
            a = __builtin_amdgcn_mfma_f32_16x16x32_bf16(uf.v, bfrag[cb], a, 0, 0, 0);
#pragma unroll
            for (int e = 0; e < 4; ++e) BUs[(quad * 4 + e) * S5_BUS + cb * 16 + l15] = a[e];
          }
          __builtin_amdgcn_wave_barrier();
#pragma unroll
          for (int i = 0; i < 16; ++i) {
            float bur = BUs[i * S5_BUS + lane], bui = BUs[i * S5_BUS + 64 + lane];
            float nr = lbr * hr - lbi * hi + bur;
            float ni = lbr * hi + lbi * hr + bui;
            hr = nr; hi = ni;
            Hs[i * S5_HS + lane] = f2bf(hr);
            Hs[i * S5_HS + 64 + lane] = f2bf(hi);
          }
          __builtin_amdgcn_wave_barrier();
          {
            f32x4 y = {0.f, 0.f, 0.f, 0.f};
#pragma unroll
            for (int ks = 0; ks < 4; ++ks) {
              bf16x8 hf = *(const bf16x8*)(Hs + l15 * S5_HS + ks * 32 + quad * 8);
              y = __builtin_amdgcn_mfma_f32_16x16x32_bf16(hf, cfrag[ks], y, 0, 0, 0);
            }
#pragma unroll
            for (int e = 0; e < 4; ++e) {
              int k = kb * 16 + quad * 4 + e;
              int t = dir ? (L - 1 - k) : k;
              ydst[(size_t)(row0 + t) * 256 + g * 16 + l15] = f2bf(y[e]);
            }
          }
          __builtin_amdgcn_wave_barrier();
          ucur = unext;
        }
        if (s < 32) {
          int oi = (((s * 2 + l) * 2 + dir) * 16 + g) * 64 + lane;
          p.out[OUT_S5RE + oi] = hr;
          p.out[OUT_S5IM + oi] = hi;
        }
        __syncthreads();
        {
          const float* dptr = p.s5_d + l * 256 + gq * 64;
#pragma unroll 4
          for (int idx = tid; idx < L * 8; idx += 512) {
            int t = idx >> 3, c8 = (idx & 7) * 8;
            size_t off = (size_t)(row0 + t) * 256 + gq * 64 + c8;
            uint4 yf = *(const uint4*)(S5Y + off), yb = *(const uint4*)(MG + off), uu = *(const uint4*)(U + off);
            float4 d0 = *(const float4*)(dptr + c8), d1 = *(const float4*)(dptr + c8 + 4);
            uint4 o;
            o.x = pack2(gelu_(lo2f(yf.x) + lo2f(yb.x) + d0.x * lo2f(uu.x)), gelu_(hi2f(yf.x) + hi2f(yb.x) + d0.y * hi2f(uu.x)));
            o.y = pack2(gelu_(lo2f(yf.y) + lo2f(yb.y) + d0.z * lo2f(uu.y)), gelu_(hi2f(yf.y) + hi2f(yb.y) + d0.w * hi2f(uu.y)));
            o.z = pack2(gelu_(lo2f(yf.z) + lo2f(yb.z) + d1.x * lo2f(uu.z)), gelu_(hi2f(yf.z) + hi2f(yb.z) + d1.y * hi2f(uu.z)));
            o.w = pack2(gelu_(lo2f(yf.w) + lo2f(yb.w) + d1.z * lo2f(uu.w)), gelu_(hi2f(yf.w) + hi2f(yb.w) + d1.w * hi2f(uu.w)));
            *(uint4*)(S5Y + off) = o;
          }
        }
        __syncthreads();
      } else if (kind == 1 || kind == 2) {
        bf16_t* KS = (bf16_t*)smem_raw;
        bf16_t* VS = (bf16_t*)(smem_raw + 65536);
        int b, h, nkeys, vss, kgld, rp = 0;
        const bf16_t *kg, *vg;
        if (kind == 2) { h = sub & 7; b = sub >> 3; nkeys = 256; vss = 264; kg = KB + (size_t)(b * 256) * 512 + h * 64; kgld = 512; vg = VTC + (size_t)((b * 8 + h) * 64) * 256; }
        else { rp = sub & 3; h = (sub >> 2) & 7; b = sub >> 5; nkeys = 512; vss = 520; kg = KC + (size_t)((b * 8 + h) * 512) * 64; kgld = 64; vg = VCT + (size_t)((b * 8 + h) * 64) * 512; }
        for (int idx = tid; idx < nkeys * 8; idx += 512) {
          int key = idx >> 3, ch = idx & 7;
          uint4 v = *(const uint4*)(kg + (size_t)key * kgld + ch * 8);
          *(uint4*)(KS + key * 64 + ((ch ^ (key & 7)) * 8)) = v;
        }
        {
          const int cpr = nkeys >> 3, sh = (kind == 2) ? 5 : 6;
          for (int idx = tid; idx < 64 * cpr; idx += 512) {
            int d = idx >> sh, ch = idx & (cpr - 1);
            uint4 v = *(const uint4*)(vg + (size_t)d * nkeys + ch * 8);
            *(uint4*)(VS + d * vss + ch * 8) = v;
          }
        }
        __syncthreads();
        {
          AttnState st0, st1;
#pragma unroll
          for (int db = 0; db < 4; ++db) { st0.o[db] = f32x4{0.f, 0.f, 0.f, 0.f}; st1.o[db] = f32x4{0.f, 0.f, 0.f, 0.f}; }
          st0.m = -1e30f; st0.lsum = 0.f; st1.m = -1e30f; st1.lsum = 0.f;
          bf16x8 qf0[2], qf1[2];
          bf16_t *orow0, *orow1;
          int r0 = 0, r1 = 0, j = 0, band0 = 0, qcol = 0, win0 = 0, nloc = 0;
          const float* rp_ = p.rpb;
          int tok0 = 0;
          if (kind == 2) {
            orow0 = QB + (size_t)(b * 256 + wave * 16 + l15) * 512 + h * 64;
            orow1 = orow0 + (size_t)128 * 512;
          } else {
            r0 = rp * 4 + (wave >> 2); r1 = r0 + 2;
            j = wave & 3;
            tok0 = 8192 + b * 1024;
            orow0 = QB + (size_t)(tok0 + r0 * 64 + j * 16 + l15) * 512 + h * 64;
            orow1 = orow0 + (size_t)128 * 512;
            band0 = min(max(j * 16 - 8, 0), 32);
            qcol = j * 16 + l15;
            win0 = min(max(qcol - 8, 0), 48);
            rp_ = p.rpb + (size_t)(l * 8 + h) * 15 * 31;
            nloc = 8;
          }
          qf0[0] = *(const bf16x8*)(orow0 + quad * 8); qf0[1] = *(const bf16x8*)(orow0 + 32 + quad * 8);
          qf1[0] = *(const bf16x8*)(orow1 + quad * 8); qf1[1] = *(const bf16x8*)(orow1 + 32 + quad * 8);
          auto softmax_pv = [&](AttnState& st, float (&sc_)[8], const bf16x8 (&va)[4]) {
            float tm = sc_[0];
#pragma unroll
            for (int i = 1; i < 8; ++i) tm = fmaxf(tm, sc_[i]);
            tm = quad_max(tm);
            if (__builtin_amdgcn_ballot_w64(tm > st.m + 8.f)) {
              float mn = fmaxf(st.m, tm);
              float alpha = __builtin_amdgcn_exp2f(st.m - mn);
              st.m = mn;
              st.lsum *= alpha;
#pragma unroll
              for (int db = 0; db < 4; ++db) { st.o[db][0] *= alpha; st.o[db][1] *= alpha; st.o[db][2] *= alpha; st.o[db][3] *= alpha; }
            }
            float pv[8];
            float ps = 0.f;
#pragma unroll
            for (int i = 0; i < 8; ++i) { pv[i] = __builtin_amdgcn_exp2f(sc_[i] - st.m); ps += pv[i]; }
            st.lsum += ps;
            union { uint4 u; bf16x8 v; } pb;
            pb.u.x = pack2(pv[0], pv[1]); pb.u.y = pack2(pv[2], pv[3]); pb.u.z = pack2(pv[4], pv[5]); pb.u.w = pack2(pv[6], pv[7]);
#pragma unroll
            for (int db = 0; db < 4; ++db) st.o[db] = __builtin_amdgcn_mfma_f32_16x16x32_bf16(va[db], pb.v, st.o[db], 0, 0, 0);
          };
          const int nct = nkeys >> 5;
          for (int t = 0; t < nct; ++t) {
            bf16x8 kf[4];
#pragma unroll
            for (int half = 0; half < 2; ++half) {
              int key = t * 32 + half * 16 + l15;
              const bf16_t* kr = KS + key * 64;
              kf[half * 2] = *(const bf16x8*)(kr + ((quad ^ (key & 7)) * 8));
              kf[half * 2 + 1] = *(const bf16x8*)(kr + (((quad + 4) ^ (key & 7)) * 8));
            }
            bf16x8 va[4];
#pragma unroll
            for (int db = 0; db < 4; ++db) {
              const bf16_t* vp = VS + (db * 16 + l15) * vss + t * 32 + quad * 4;
              uint2 lo = *(const uint2*)vp, hi = *(const uint2*)(vp + 16);
              union { uint4 u; bf16x8 v; } x; x.u.x = lo.x; x.u.y = lo.y; x.u.z = hi.x; x.u.w = hi.y;
              va[db] = x.v;
            }
            float sa[8], sb[8];
#pragma unroll
            for (int half = 0; half < 2; ++half) {
              f32x4 a0 = {0.f, 0.f, 0.f, 0.f}, a1 = {0.f, 0.f, 0.f, 0.f};
              a0 = __builtin_amdgcn_mfma_f32_16x16x32_bf16(kf[half * 2], qf0[0], a0, 0, 0, 0);
              a1 = __builtin_amdgcn_mfma_f32_16x16x32_bf16(kf[half * 2], qf1[0], a1, 0, 0, 0);
              a0 = __builtin_amdgcn_mfma_f32_16x16x32_bf16(kf[half * 2 + 1], qf0[1], a0, 0, 0, 0);
              a1 = __builtin_amdgcn_mfma_f32_16x16x32_bf16(kf[half * 2 + 1], qf1[1], a1, 0, 0, 0);
#pragma unroll
              for (int e = 0; e < 4; ++e) { sa[half * 4 + e] = a0[e]; sb[half * 4 + e] = a1[e]; }
            }
            softmax_pv(st0, sa, va);
            softmax_pv(st1, sb, va);
          }
          auto run_local = [&](AttnState& st, const bf16x8 (&qf)[2], int r) {
            const int rbase = min(max(r - 4, 0), 8);
            const bf16_t* k2 = KB + (size_t)(tok0 + rbase * 64 + band0) * 512 + h * 64;
            const bf16_t* v2 = VTL + (size_t)((b * 8 + h) * 64) * 1024 + rbase * 64 + band0;
            auto load_k = [&](int w, bf16x8 (&kk)[4]) {
              const bf16_t* kb_ = k2 + (size_t)(w * 64) * 512;
#pragma unroll
              for (int half = 0; half < 2; ++half) {
                const bf16_t* kp = kb_ + (size_t)(half * 16 + l15) * 512 + quad * 8;
                kk[half * 2] = *(const bf16x8*)kp;
                kk[half * 2 + 1] = *(const bf16x8*)(kp + 32);
              }
            };
            auto do_local = [&](int w, const bf16x8 (&kk)[4]) {
              uint2 vv[8];
              {
                const bf16_t* vt_ = v2 + w * 64;
#pragma unroll
                for (int db = 0; db < 4; ++db) {
                  const bf16_t* vp = vt_ + (size_t)(db * 16 + l15) * 1024 + quad * 4;
                  vv[db * 2] = *(const uint2*)vp;
                  vv[db * 2 + 1] = *(const uint2*)(vp + 16);
                }
              }
              float sc_[8];
#pragma unroll
              for (int half = 0; half < 2; ++half) {
                f32x4 acc = {0.f, 0.f, 0.f, 0.f};
                acc = __builtin_amdgcn_mfma_f32_16x16x32_bf16(kk[half * 2], qf[0], acc, 0, 0, 0);
                acc = __builtin_amdgcn_mfma_f32_16x16x32_bf16(kk[half * 2 + 1], qf[1], acc, 0, 0, 0);
#pragma unroll
                for (int e = 0; e < 4; ++e) sc_[half * 4 + e] = acc[e];
              }
              int rr = rbase + w;
              int dy = rr - r + 7;
#pragma unroll
              for (int i = 0; i < 8; ++i) {
                int kc = band0 + (i >> 2) * 16 + quad * 4 + (i & 3);
                bool valid = (kc >= win0) && (kc < win0 + 16);
                int dx = min(max(kc - qcol + 15, 0), 30);
                float bias = rp_[dy * 31 + dx] * 1.4426950408889634f;
                sc_[i] = valid ? sc_[i] + bias : -1e30f;
              }
              bf16x8 va[4];
#pragma unroll
              for (int db = 0; db < 4; ++db) {
                union { uint4 u; bf16x8 v; } x; x.u.x = vv[db * 2].x; x.u.y = vv[db * 2].y; x.u.z = vv[db * 2 + 1].x; x.u.w = vv[db * 2 + 1].y;
                va[db] = x.v;
              }
              softmax_pv(st, sc_, va);
            };
            bf16x8 kA[4], kB[4];
            load_k(0, kA);
#pragma unroll 1
            for (int w = 0; w < 8; w += 2) {
              load_k(w + 1, kB);
              do_local(w, kA);
              if (w + 2 < 8) load_k(w + 2, kA);
              do_local(w + 1, kB);
            }
          };
          if (nloc) { run_local(st0, qf0, r0); run_local(st1, qf1, r1); }
          {
            float inv0 = __builtin_amdgcn_rcpf(quad_sum(st0.lsum)), inv1 = __builtin_amdgcn_rcpf(quad_sum(st1.lsum));
#pragma unroll
            for (int db = 0; db < 4; ++db) {
              uint2 pk;
              pk.x = pack2(st0.o[db][0] * inv0, st0.o[db][1] * inv0);
              pk.y = pack2(st0.o[db][2] * inv0, st0.o[db][3] * inv0);
              *(uint2*)(orow0 + db * 16 + quad * 4) = pk;
              pk.x = pack2(st1.o[db][0] * inv1, st1.o[db][1] * inv1);
              pk.y = pack2(st1.o[db][2] * inv1, st1.o[db][3] * inv1);
              *(uint2*)(orow1 + db * 16 + quad * 4) = pk;
            }
          }
        }
      } else {
        int ch = tid & 255;
        int r0 = sub * 128 + (tid >> 8) * 64;
        int L = r0 < 8192 ? 256 : 1024;
        float w0 = p.lru_conv_w[l * 1024 + ch], w1 = p.lru_conv_w[l * 1024 + 256 + ch];
        float w2 = p.lru_conv_w[l * 1024 + 512 + ch], w3 = p.lru_conv_w[l * 1024 + 768 + ch];
        float cb = p.lru_conv_b[l * 256 + ch];
#pragma unroll 1
        for (int c0 = 0; c0 < 64; c0 += 16) {
          int rc = r0 + c0;
          int tc = rc & (L - 1);
          const bf16_t* xp = XR + (size_t)rc * 256 + ch;
          float xv[19];
#pragma unroll
          for (int i = 0; i < 19; ++i) {
            int tt = tc + i - 2;
            xv[i] = (tt >= 0 && tt < L) ? bf2f(xp[(i - 2) * 256]) : 0.f;
          }
#pragma unroll
          for (int i = 0; i < 16; ++i)
            LRUY[(size_t)(rc + i) * 256 + ch] = f2bf(cb + w0 * xv[i] + w1 * xv[i + 1] + w2 * xv[i + 2] + w3 * xv[i + 3]);
        }
      }
    }
    GSYNC();

    const float* const lba = p.lru_b_a + l * 512;
    const float* const lbx = p.lru_b_x + l * 512;
    PH(3) run_gemm(lds, LRUY, 256, WT + WT_LRU, 256, 1024, 256, [=](int row, int col, f32x4 v) {
      int dir = col >> 9, gate = (col >> 8) & 1, ch = col & 255;
      f32x4 bias = *(const f32x4*)((gate ? lbx : lba) + dir * 256 + ch);
      float s0 = sigmoidf_(v[0] + bias[0]), s1 = sigmoidf_(v[1] + bias[1]), s2 = sigmoidf_(v[2] + bias[2]), s3 = sigmoidf_(v[3] + bias[3]);
      if (gate) {
        uint2 xc = *(const uint2*)(LRUY + (size_t)row * 256 + ch);
        s0 *= lo2f(xc.x); s1 *= hi2f(xc.x); s2 *= lo2f(xc.y); s3 *= hi2f(xc.y);
      }
      uint2 o; o.x = pack2(s0, s1); o.y = pack2(s2, s3);
      *(uint2*)(MG + (size_t)row * 1024 + col) = o;
    });
    __builtin_amdgcn_sched_barrier(0);
    __builtin_amdgcn_sched_barrier(0);
    PH(10) run_gemm(lds, S5Y, 256, WT + WT_GLU, 256, 256, 256, [=](int row, int col, f32x4 v) {
      uint2 yy = *(const uint2*)(S5Y + (size_t)row * 256 + col);
      uint2 o;
      o.x = pack2(lo2f(yy.x) * sigmoidf_(v[0]), hi2f(yy.x) * sigmoidf_(v[1]));
      o.y = pack2(lo2f(yy.y) * sigmoidf_(v[2]), hi2f(yy.y) * sigmoidf_(v[3]));
      *(uint2*)(U + (size_t)row * 256 + col) = o;
    });
    GSYNC();

    PH(4) for (;;) {
      LAUNDER_TID();
      if (tid == 0) xb_st[2] = xb_add(&BAR[XB_WQ(l * 2 + 1)], 1u);
      __syncthreads();
      const int qi = (int)xb_st[2];
      __syncthreads();
      if (qi >= 320) break;
      const int item = qi < 64 ? 256 + qi : qi - 64;
      const int s = item >> 3, ch0 = (item & 7) * 32;
      const int L = s < 32 ? 256 : 1024;
      const int Lq = L >> 3;
      const int row0 = s < 32 ? s * 256 : 8192 + (s - 32) * 1024;
      const int dir = lane >> 5, q = wave;
      const int ch = ch0 + (lane & 31);
      float* E_ = (float*)smem_raw;
      float* PT = E_ + 512;
      float* CAR = PT + 512;
      float lam = p.lru_lam[l * 512 + dir * 256 + ch];
      float sp = log1pf(expf(-lam));
      float h = 0.f, P = 1.f;
      bf16_t* base = MG + dir * 512 + ch;
      {
        const int kbeg = q * Lq, kend = (q + 1) * Lq;
        uint32_t cur[8], nxt[8];
        auto ld8 = [&](int kb, uint32_t (&d)[8]) {
#pragma unroll
          for (int i = 0; i < 8; ++i) {
            int k = kb + i;
            int t = dir ? (L - 1 - k) : k;
            const bf16_t* qq = base + (size_t)(row0 + t) * 1024;
            d[i] = (uint32_t)qq[0] | ((uint32_t)qq[256] << 16);
          }
        };
        ld8(kbeg, cur);
        for (int kb = kbeg; kb < kend; kb += 8) {
          if (kb + 8 < kend) ld8(kb + 8, nxt);
          float hv[8], pv_[8];
#pragma unroll
          for (int i = 0; i < 8; ++i) {
            float rvv = lo2f(cur[i]), xvv = hi2f(cur[i]);
            float la = -8.f * rvv * sp;
            float a = __expf(la);
            float x2 = 2.f * la;
            float ser = -x2 * (1.f + x2 * (0.5f + x2 * (0.16666667f + x2 * (0.041666668f + x2 * (0.0083333338f + x2 * 0.0013888889f)))));
            float om = x2 > -0.25f ? ser : 1.f - a * a;
            float bm = __builtin_amdgcn_sqrtf(fmaxf(om, 0.f)) * xvv;
            h = a * h + bm;
            P = a * P;
            hv[i] = h; pv_[i] = P;
          }
#pragma unroll
          for (int i = 0; i < 8; ++i) {
            int k = kb + i;
            int t = dir ? (L - 1 - k) : k;
            bf16_t* qq = base + (size_t)(row0 + t) * 1024;
            uint32_t pk = pack2(hv[i], pv_[i]);
            qq[0] = (bf16_t)(pk & 0xffffu);
            qq[256] = (bf16_t)(pk >> 16);
          }
#pragma unroll
          for (int i = 0; i < 8; ++i) cur[i] = nxt[i];
        }
      }
      E_[wave * 64 + lane] = h;
      PT[wave * 64 + lane] = P;
      __syncthreads();
      {
        float c = 0.f;
        if (s >= 32) c = p.st_lru[(((s - 32) * 2 + l) * 2 + dir) * 256 + ch];
        for (int q2 = 0; q2 < q; ++q2) c = PT[q2 * 64 + lane] * c + E_[q2 * 64 + lane];
        CAR[wave * 64 + lane] = c;
        if (q == 7 && s < 32) p.out[OUT_LRU + ((s * 2 + l) * 2 + dir) * 256 + ch] = P * c + h;
      }
      __syncthreads();
      {
#pragma unroll 2
        for (int idx = tid; idx < L * 4; idx += 512) {
          int t = idx >> 2, c8 = (idx & 3) * 8;
          int qf_ = t / Lq, qb_ = (L - 1 - t) / Lq;
          size_t row = row0 + t;
          const bf16_t* mp = MG + row * 1024 + ch0 + c8;
          uint4 h0 = *(const uint4*)mp, p0 = *(const uint4*)(mp + 256), h1 = *(const uint4*)(mp + 512), p1 = *(const uint4*)(mp + 768);
          uint4 gg = *(const uint4*)(XG + row * 256 + ch0 + c8);
          const float* cf = CAR + qf_ * 64 + c8;
          const float* cbk = CAR + qb_ * 64 + 32 + c8;
          float4 cf0 = *(const float4*)cf, cf1 = *(const float4*)(cf + 4), cb0 = *(const float4*)cbk, cb1 = *(const float4*)(cbk + 4);
          uint4 o;
          o.x = pack2((lo2f(h0.x) + lo2f(p0.x) * cf0.x + lo2f(h1.x) + lo2f(p1.x) * cb0.x) * gelu_(lo2f(gg.x)),
                      (hi2f(h0.x) + hi2f(p0.x) * cf0.y + hi2f(h1.x) + hi2f(p1.x) * cb0.y) * gelu_(hi2f(gg.x)));
          o.y = pack2((lo2f(h0.y) + lo2f(p0.y) * cf0.z + lo2f(h1.y) + lo2f(p1.y) * cb0.z) * gelu_(lo2f(gg.y)),
                      (hi2f(h0.y) + hi2f(p0.y) * cf0.w + hi2f(h1.y) + hi2f(p1.y) * cb0.w) * gelu_(hi2f(gg.y)));
          o.z = pack2((lo2f(h0.z) + lo2f(p0.z) * cf1.x + lo2f(h1.z) + lo2f(p1.z) * cb1.x) * gelu_(lo2f(gg.z)),
                      (hi2f(h0.z) + hi2f(p0.z) * cf1.y + hi2f(h1.z) + hi2f(p1.z) * cb1.y) * gelu_(hi2f(gg.z)));
          o.w = pack2((lo2f(h0.w) + lo2f(p0.w) * cf1.z + lo2f(h1.w) + lo2f(p1.w) * cb1.z) * gelu_(lo2f(gg.w)),
                      (hi2f(h0.w) + hi2f(p0.w) * cf1.w + hi2f(h1.w) + hi2f(p1.w) * cb1.w) * gelu_(hi2f(gg.w)));
          *(uint4*)(LRUY + row * 256 + ch0 + c8) = o;
        }
      }
      __syncthreads();
    }
    GSYNC();

    PH(5) {
      pg8::StaticOrder S; S.init(16384, 1024, gridDim.x, blockIdx.x);
      int k0 = 512, k12 = 256;
      asm volatile("" : "+s"(k0), "+s"(k12));
      const unsigned char* const Gp = G8;
      bf16_t* const MGp = MG;
      pg8::gemm_phase_seg(lds, QB, U, LRUY, WT + WT_BRA, WT + WT_BRS, WT + WT_BRL, k0, k12, S,
        pg8::make_epi_seg(
          [=](int row, int col, int seg) -> uint2 {
            const unsigned char* gp = Gp + (size_t)row * 3072 + col;
            uint2 r;
            r.x = *(const uint32_t*)(gp + seg * 1024);
            r.y = *(const uint32_t*)(gp + (seg < 2 ? seg + 1 : 2) * 1024);
            return r;
          },
          [=](int row, int col, f32x4& v, int seg, uint2 g) {
          const uint32_t ga = g.x, gb = g.y;
          float a0 = (float)max((int)(ga & 255u), 1), a1 = (float)max((int)((ga >> 8) & 255u), 1);
          float a2 = (float)max((int)((ga >> 16) & 255u), 1), a3 = (float)max((int)(ga >> 24), 1);
          if (seg < 2) {
            float b0 = (float)max((int)(gb & 255u), 1), b1 = (float)max((int)((gb >> 8) & 255u), 1);
            float b2 = (float)max((int)((gb >> 16) & 255u), 1), b3 = (float)max((int)(gb >> 24), 1);
            v[0] = v[0] * (a0 * __builtin_amdgcn_rcpf(b0)); v[1] = v[1] * (a1 * __builtin_amdgcn_rcpf(b1)); v[2] = v[2] * (a2 * __builtin_amdgcn_rcpf(b2)); v[3] = v[3] * (a3 * __builtin_amdgcn_rcpf(b3));
          } else {
            const float sc_ = 1.f / 255.f;
            uint2 o; o.x = pack2(v[0] * (a0 * sc_), v[1] * (a1 * sc_)); o.y = pack2(v[2] * (a2 * sc_), v[3] * (a3 * sc_));
            *(uint2*)(MGp + (size_t)row * 1024 + col) = o;
          }
        }));
    }
    GSYNC();

    const float* const xin0 = p.x_prompt;
    const float* const xin1 = p.x_sample;
    PH(6) run_gemm(lds, MG, 1024, WT + WT_OUT, 1024, 1024, 1024, [=](int row, int col, f32x4 v) {
      f32x4 gt = *(const f32x4*)(MOD + (size_t)modrow(row) * 6144 + 2048 + col);
      const float* xs = l == 0 ? (row < 8192 ? xin0 + (size_t)row * 1024 : xin1 + (size_t)(row - 8192) * 1024) : X + (size_t)row * 1024;
      f32x4 xv = *(const f32x4*)(xs + col);
      *(f32x4*)(X + (size_t)row * 1024 + col) = xv + gt * v;
    });
    GSYNC();

    PH(13) norm_phase(p, l, 1, false, tid);
    GSYNC();

    bf16_t* const FAB = (bf16_t*)UB;
    PH(7) run_gemm(lds, HBUF, 1024, WT + WT_UP, 1024, 5632, 1024, [=](int row, int col, f32x4 v) {
      uint2 o; o.x = pack2(v[0], v[1]); o.y = pack2(v[2], v[3]);
      *(uint2*)(FAB + (size_t)row * 5632 + col) = o;
    });
    GSYNC();

    {
      LAUNDER_TID();
      const float* const fcw = p.ffn_conv_w + l * 3 * 2816;
      const float* const fcb = p.ffn_conv_b + l * 2816;
      for (int it = blockIdx.x * 512 + tid; it < 1024 * 352; it += gridDim.x * 512) {
        int rb = it / 352, cc = it - rb * 352;
        int r0 = rb * 16, col = cc * 8;
        int L = r0 < 8192 ? 256 : 1024;
        int t0 = r0 & (L - 1);
        const float* cw = fcw + col;
        float4 w0a = *(const float4*)cw, w0b = *(const float4*)(cw + 4);
        float4 w1a = *(const float4*)(cw + 2816), w1b = *(const float4*)(cw + 2820);
        float4 w2a = *(const float4*)(cw + 5632), w2b = *(const float4*)(cw + 5636);
        float4 cba = *(const float4*)(fcb + col), cbb = *(const float4*)(fcb + col + 4);
        const bf16_t* ap = FAB + (size_t)r0 * 5632 + col;
        bf16_t* bp = FAB + (size_t)r0 * 5632 + 2816 + col;
        uint4 am1 = make_uint4(0, 0, 0, 0);
        if (t0 > 0) am1 = *(const uint4*)(ap - 5632);
        uint4 a0 = *(const uint4*)ap;
        const bool tail_ok = (t0 + 16 < L);
#pragma unroll 1
        for (int i0 = 0; i0 < 16; i0 += 4) {
          uint4 an[4], bb[4];
#pragma unroll
          for (int jj = 0; jj < 4; ++jj) {
            int i = i0 + jj;
            an[jj] = make_uint4(0, 0, 0, 0);
            if (i < 15 || tail_ok) an[jj] = *(const uint4*)(ap + (size_t)(i + 1) * 5632);
            bb[jj] = *(const uint4*)(bp + (size_t)i * 5632);
          }
#pragma unroll
          for (int jj = 0; jj < 4; ++jj) {
            uint4 o;
            {
              float x0 = cba.x + w0a.x * lo2f(am1.x) + w1a.x * lo2f(a0.x) + w2a.x * lo2f(an[jj].x);
              float x1 = cba.y + w0a.y * hi2f(am1.x) + w1a.y * hi2f(a0.x) + w2a.y * hi2f(an[jj].x);
              o.x = pack2(gelu_(x0) * lo2f(bb[jj].x), gelu_(x1) * hi2f(bb[jj].x));
              float x2 = cba.z + w0a.z * lo2f(am1.y) + w1a.z * lo2f(a0.y) + w2a.z * lo2f(an[jj].y);
              float x3 = cba.w + w0a.w * hi2f(am1.y) + w1a.w * hi2f(a0.y) + w2a.w * hi2f(an[jj].y);
              o.y = pack2(gelu_(x2) * lo2f(bb[jj].y), gelu_(x3) * hi2f(bb[jj].y));
              float x4 = cbb.x + w0b.x * lo2f(am1.z) + w1b.x * lo2f(a0.z) + w2b.x * lo2f(an[jj].z);
              float x5 = cbb.y + w0b.y * hi2f(am1.z) + w1b.y * hi2f(a0.z) + w2b.y * hi2f(an[jj].z);
              o.z = pack2(gelu_(x4) * lo2f(bb[jj].z), gelu_(x5) * hi2f(bb[jj].z));
              float x6 = cbb.z + w0b.z * lo2f(am1.w) + w1b.z * lo2f(a0.w) + w2b.z * lo2f(an[jj].w);
              float x7 = cbb.w + w0b.w * hi2f(am1.w) + w1b.w * hi2f(a0.w) + w2b.w * hi2f(an[jj].w);
              o.w = pack2(gelu_(x6) * lo2f(bb[jj].w), gelu_(x7) * hi2f(bb[jj].w));
            }
            *(uint4*)(bp + (size_t)(i0 + jj) * 5632) = o;
            am1 = a0; a0 = an[jj];
          }
        }
      }
    }
    GSYNC();

    PH(9) run_gemm(lds, FAB + 2816, 5632, WT + WT_DOWN, 2816, 1024, 2816, [=](int row, int col, f32x4 v) {
      f32x4 gt = *(const f32x4*)(MOD + (size_t)modrow(row) * 6144 + 5120 + col);
      f32x4* xp = (f32x4*)(X + (size_t)row * 1024 + col);
      *xp = *xp + gt * v;
    });
    GSYNC();
  }

  {
  LAUNDER_TID();
  for (int r = blockIdx.x * 8 + wave; r < 16384; r += gridDim.x * 8) {
    float* xr = X + (size_t)r * 1024;
    float4 v[4];
    float ss = 0.f;
#pragma unroll
    for (int i = 0; i < 4; ++i) {
      v[i] = *(const float4*)(xr + i * 256 + lane * 4);
      ss += v[i].x * v[i].x + v[i].y * v[i].y + v[i].z * v[i].z + v[i].w * v[i].w;
    }
#pragma unroll
    for (int o = 32; o >= 1; o >>= 1) ss += __shfl_xor(ss, o);
    float rstd = rsqrtf(ss * (1.f / 1024.f) + 1e-6f);
#pragma unroll
    for (int i = 0; i < 4; ++i) {
      int c = i * 256 + lane * 4;
      float4 gg = *(const float4*)(p.g_final + c);
      float4 o;
      o.x = v[i].x * rstd * gg.x; o.y = v[i].y * rstd * gg.y; o.z = v[i].z * rstd * gg.z; o.w = v[i].w * rstd * gg.w;
      *(float4*)(xr + c) = o;
    }
  }
  }
}

extern "C" void kernel_launch(void* const* d_in, const int* in_sizes, int n_in, void* d_out, int out_size, void* d_ws,
                              size_t ws_size, hipStream_t stream) {
  static int grid_blocks = 0;
  if (!grid_blocks) {
    int dev = 0, cus = 0;
    (void)hipGetDevice(&dev);
    (void)hipDeviceGetAttribute(&cus, hipDeviceAttributeMultiprocessorCount, dev);
    (void)hipFuncSetAttribute((const void*)mega, hipFuncAttributeMaxDynamicSharedMemorySize, LDS_BYTES);
    int per_cu = 0;
    (void)hipOccupancyMaxActiveBlocksPerMultiprocessor(&per_cu, (const void*)mega, 512, LDS_BYTES);
    (void)hipGetLastError();
    grid_blocks = cus > 0 ? cus : 256;
  }
  Params p{};
  const float** pp = (const float**)&p;
  for (int i = 0; i < 40; ++i) pp[i] = (const float*)d_in[i];
  p.out = (float*)d_out;
  p.ws = (char*)d_ws;
  (void)hipMemsetAsync((char*)d_ws + WS_BAR, 0, XCD_BAR_WORDS * 4, stream);
  void* args[] = {&p};
  hipError_t e = hipLaunchCooperativeKernel((const void*)mega, dim3(grid_blocks), dim3(512), args, LDS_BYTES, stream);
  if (e != hipSuccess) fprintf(stderr, "cooperative launch failed: %s (grid %d)\n", hipGetErrorString(e), grid_blocks);
}
```

```cpp
#include <hip/hip_runtime.h>
#include <hip/hip_cooperative_groups.h>
#include <stdint.h>
#include <cstdio>
namespace cg = cooperative_groups;

#define LAS __attribute__((address_space(3)))
typedef unsigned short bf16_t;
typedef short bf16x8 __attribute__((ext_vector_type(8)));
typedef float f32x4 __attribute__((ext_vector_type(4)));

struct Params {
  const float *x_prompt, *x_sample, *cache_k, *cache_v, *st_s5_re, *st_s5_im, *st_lru, *c, *c_ctx;
  const float *w_ada, *b_ada, *g1, *g2, *w_in, *rpb;
  const float *s5_lam_re, *s5_lam_im, *s5_log_step, *s5_b_re, *s5_b_im, *s5_c_re, *s5_c_im, *s5_d, *s5_w_glu;
  const float *lru_conv_w, *lru_conv_b, *lru_w_a, *lru_b_a, *lru_w_x, *lru_b_x, *lru_lam;
  const float *w_br_attn, *w_br_s5, *w_br_lru, *w_out, *ffn_w_up, *ffn_conv_w, *ffn_conv_b, *ffn_w_down, *g_final;
  float* out;
  char* ws;
};

#define OUT_NEWK 16777216
#define OUT_NEWV 25165824
#define OUT_S5RE 33554432
#define OUT_S5IM 33685504
#define OUT_LRU 33816576

#define WS_MOD 0
#define WS_WT 524288
#define WT_IN 0
#define WT_BRA 5505024
#define WT_BRS 6029312
#define WT_BRL 6291456
#define WT_OUT 6553600
#define WT_UP 7602176
#define WT_DOWN 13369344
#define WT_GLU 16252928
#define WT_LRU 16318464
#define WS_HBUF 33685504
#define WS_UB 67239936
#define UB_QB 0
#define UB_KB 16777216
#define UB_VTC 33554432
#define UB_VTL 41943040
#define UB_U 50331648
#define UB_XR 58720256
#define UB_XG 67108864
#define UB_S5Y 75497472
#define UB_LRUY 83886080
#define UB_MG 92274688
#define UB_KC 125829120
#define UB_VCT 130023424
#define UB_G8 134217728
#define UB_FA 0
#define UB_ACT 92274688
#define LDS_BYTES 132160
#ifndef PHASE_MASK
#define PHASE_MASK 0xffff
#endif
#define GSYNC() do { xcd_barrier(xb); if ((REP_MASK >> 14) & 1) xcd_barrier(xb); } while (0)
#ifndef REP_MASK
#define REP_MASK 0
#endif
#define PH(k) for (int rep_ = 0; rep_ < ((REP_MASK >> (k)) & 1) + 1; ++rep_) if (PHASE_MASK & (1 << (k)))
#define LAUNDER_TID() int tid = threadIdx.x; asm volatile("" : "+v"(tid)); const int lane = tid & 63, wave = tid >> 6, l15 = lane & 15, quad = lane >> 4; (void)lane; (void)wave; (void)l15; (void)quad

__device__ __forceinline__ uint32_t pack2(float a, float b) {
  uint32_t r;
  asm("v_cvt_pk_bf16_f32 %0, %1, %2" : "=v"(r) : "v"(a), "v"(b));
  return r;
}
__device__ __forceinline__ bf16_t f2bf(float f) { return (bf16_t)(pack2(f, 0.f) & 0xffffu); }
__device__ __forceinline__ float bf2f(bf16_t b) { return __uint_as_float(((uint32_t)b) << 16); }
__device__ __forceinline__ float lo2f(uint32_t u) { return __uint_as_float(u << 16); }
__device__ __forceinline__ float hi2f(uint32_t u) { return __uint_as_float(u & 0xffff0000u); }
__device__ __forceinline__ float sigmoidf_(float x) { return __builtin_amdgcn_rcpf(1.f + __expf(-x)); }
__device__ __forceinline__ float gelu_(float x) {
  float z = 0.7978845608028654f * (x + 0.044715f * x * x * x);
  float t = 1.f - 2.f * __builtin_amdgcn_rcpf(1.f + __expf(2.f * z));
  return 0.5f * x * (1.f + t);
}
__device__ __forceinline__ float quad_max(float x) {
  unsigned u = __float_as_uint(x);
  auto r = __builtin_amdgcn_permlane32_swap(u, u, false, false);
  float m = fmaxf(__uint_as_float(r[0]), __uint_as_float(r[1]));
  unsigned u2 = __float_as_uint(m);
  auto r2 = __builtin_amdgcn_permlane16_swap(u2, u2, false, false);
  return fmaxf(__uint_as_float(r2[0]), __uint_as_float(r2[1]));
}
__device__ __forceinline__ float quad_sum(float x) {
  unsigned u = __float_as_uint(x);
  auto r = __builtin_amdgcn_permlane32_swap(u, u, false, false);
  float m = __uint_as_float(r[0]) + __uint_as_float(r[1]);
  unsigned u2 = __float_as_uint(m);
  auto r2 = __builtin_amdgcn_permlane16_swap(u2, u2, false, false);
  return __uint_as_float(r2[0]) + __uint_as_float(r2[1]);
}
typedef float f32x4nt __attribute__((ext_vector_type(4)));
__device__ __forceinline__ float4 ld_nt4(const float* p) {
  f32x4nt v = __builtin_nontemporal_load((const f32x4nt*)p);
  return make_float4(v[0], v[1], v[2], v[3]);
}
__device__ __forceinline__ int modrow(int r) { return r < 8192 ? 0 : 1 + ((r - 8192) >> 10); }


#define WS_BAR 458752
#define XB_TMO      128
#define XB_XCNT(j)  (256  + 64 * (j))
#define XB_XSUB(j)  (1280 + 64 * (j))
#define XB_XGEN(j)  (2304 + 64 * (j))
#define XB_TOP      3328
#define XB_TOPGEN   3392
#define XB_WQ(i)    (3456 + 64 * (i))
#define XCD_BAR_WORDS 4096
#define XB_SPIN_CAP (1u << 18)
__device__ __forceinline__ unsigned xb_ld(unsigned* p) { return __hip_atomic_load(p, __ATOMIC_RELAXED, __HIP_MEMORY_SCOPE_AGENT); }
__device__ __forceinline__ unsigned xb_add(unsigned* p, unsigned v) { return __hip_atomic_fetch_add(p, v, __ATOMIC_RELAXED, __HIP_MEMORY_SCOPE_AGENT); }
__device__ __forceinline__ unsigned xb_xcc_id() { return (unsigned)__builtin_amdgcn_s_getreg((3 << 11) | 20) & 0xFu; }
#define XB_SPIN(cond, bar) do { unsigned _sp = 0; while (cond) { __builtin_amdgcn_s_sleep(1); \
    if ((++_sp & 255u) == 0u) { if (xb_ld(&(bar)[XB_TMO])) break; if (_sp > XB_SPIN_CAP) { atomicAdd(&(bar)[XB_TMO], 1u); break; } } } } while (0)
struct XcdBarrier { unsigned* bar; unsigned x; volatile LAS unsigned* st; };
__device__ __forceinline__ XcdBarrier xcd_barrier_post(unsigned* bar, volatile LAS unsigned* st) {
  XcdBarrier b; b.bar = bar; b.x = xb_xcc_id(); b.st = st;
  if (threadIdx.x == 0) (void)xb_add(&bar[XB_XCNT(b.x)], 1u);
  return b;
}
__device__ __forceinline__ void xcd_barrier_complete(unsigned* bar, unsigned x, unsigned& nloc, unsigned& nx) {
  const unsigned G = gridDim.x * gridDim.y * gridDim.z;
  unsigned sum, cnt, mine, sp = 0u;
  for (;;) {
    sum = 0u; cnt = 0u; mine = 0u;
#pragma unroll
    for (unsigned j = 0; j < 16; ++j) { const unsigned c = xb_ld(&bar[XB_XCNT(j)]); sum += c; cnt += (c > 0u) ? 1u : 0u; mine = (j == x) ? c : mine; }
    if (sum == G) break;
    __builtin_amdgcn_s_sleep(1);
    if ((++sp & 255u) == 0u) { if (xb_ld(&bar[XB_TMO])) break; if (sp > XB_SPIN_CAP) { atomicAdd(&bar[XB_TMO], 1u); break; } }
  }
  nloc = mine > 0u ? mine : 1u; nx = cnt > 0u ? cnt : 1u;
}
__device__ __forceinline__ void xcd_barrier(const XcdBarrier& b) {
  asm volatile("s_waitcnt vmcnt(0)" ::: "memory");
  __syncthreads();
  if (threadIdx.x == 0) {
    unsigned* bar = b.bar;
    __builtin_amdgcn_s_waitcnt(0);
    unsigned nloc = b.st[0], nx = b.st[1];
    if (nloc == 0u) { xcd_barrier_complete(bar, b.x, nloc, nx); b.st[0] = nloc; b.st[1] = nx; }
    const unsigned old = xb_add(&bar[XB_XSUB(b.x)], 1u);
    const unsigned gen = old / nloc;
    if (old + 1u == (gen + 1u) * nloc) {
      __builtin_amdgcn_fence(__ATOMIC_RELEASE, "agent");
      asm volatile("s_waitcnt vmcnt(0)" ::: "memory");
      const unsigned og = xb_add(&bar[XB_TOP], 1u);
      const unsigned tg = og / nx;
      if (og + 1u == (tg + 1u) * nx) xb_add(&bar[XB_TOPGEN], 1u);
      else XB_SPIN(xb_ld(&bar[XB_TOPGEN]) == tg, bar);
      __builtin_amdgcn_fence(__ATOMIC_ACQUIRE, "agent");
      xb_add(&bar[XB_XGEN(b.x)], 1u);
      asm volatile("s_waitcnt vmcnt(0)" ::: "memory");
    } else {
      XB_SPIN(xb_ld(&bar[XB_XGEN(b.x)]) == gen, bar);
      __builtin_amdgcn_fence(__ATOMIC_ACQUIRE, "agent");
      asm volatile("s_waitcnt vmcnt(0)" ::: "memory");
    }
  }
  __syncthreads();
}

namespace pg8 {
constexpr int BM = 256, BK = 64, HALF = 128, HTB = HALF * BK * 2, NXCD = 8, WGM = 8;
__device__ __forceinline__ int lds_byte(int r, int c) { const int st = (r >> 4) * 2 + (c >> 5), rr = r & 15, cc = c & 31, ob = rr * 64 + cc * 2; return st * 1024 + (ob ^ (((ob >> 9) & 1) << 5)); }
__device__ __forceinline__ void stage_rc(int b, int& R, int& C) { const int st = b / 1024, sb = b % 1024, swz = sb ^ (((sb >> 9) & 1) << 5); R = (st >> 1) * 16 + swz / 64; C = (st & 1) * 32 + (swz % 64) / 2; }
struct Unit { int pm, pn; };
struct Gemm { const bf16_t* A; const bf16_t* Bt; int lda, ldb, K; };
struct StaticOrder {
  int nM, nN, nwg, G, c;
  __device__ void init(int M, int N, int G_, int c_) { nM = M / BM; nN = N / BM; nwg = nM * nN; G = G_; c = c_; }
  __device__ bool next(int i, Unit& u) const {
    const long L = (long)i * G + c; if (L >= nwg) return false;
    int wgid = (int)L; { const int q = nwg / NXCD, r = nwg % NXCD, xcd = wgid % NXCD, off = wgid / NXCD; wgid = (xcd < r ? xcd * (q + 1) : r * (q + 1) + (xcd - r) * q) + off; }
    const int nig = WGM * nN, gid = wgid / nig, fm = gid * WGM, gsz = (nM - fm) < WGM ? (nM - fm) : WGM;
    u.pm = fm + ((wgid % nig) % gsz); u.pn = (wgid % nig) / gsz; return true;
  }
};

template <class Epi>
__device__ __forceinline__ void gemm_phase(LAS unsigned char* lds, const Gemm g, const StaticOrder& S, const Epi& E) {
  int tid = threadIdx.x; asm volatile("" : "+v"(tid));
  const int wid = __builtin_amdgcn_readfirstlane(tid >> 6), lane = tid & 63, wr = wid >> 2, wc = wid & 3, fr = lane & 15, fq = lane >> 4;
  const int K = g.K, nt = K / BK;
  unsigned voffA[2], voffB[2];
#pragma unroll
  for (int i = 0; i < 2; ++i) { int R, C; stage_rc(tid * 16 + i * 8192, R, C);
    voffA[i] = (unsigned)(R * g.lda + C) * 2u; voffB[i] = (unsigned)(R * g.ldb + C) * 2u; }
  asm volatile("" : "+v"(voffA[0]), "+v"(voffA[1]), "+v"(voffB[0]), "+v"(voffB[1]));
  const size_t kstep = (size_t)(BK * 2);
  const size_t hstepA = (size_t)HALF * g.lda * 2, hstepB = (size_t)HALF * g.ldb * 2;
  const size_t tstepA = 2 * hstepA, tstepB = 2 * hstepB;
  const unsigned ldsw = (unsigned)wid * 1024u;
  const int aoff = lds_byte(wr * 64 + fr, fq * 8), boff = lds_byte(wc * 32 + fr, fq * 8);
#define PG8_SA(b, h) (((b) * 2 + (h)) * HTB)
#define PG8_SB(b, h) ((4 + (b) * 2 + (h)) * HTB)
#define PG8_STAGE(bufoff, gbase, voff) do { _Pragma("unroll") for (int _i = 0; _i < 2; ++_i) \
    __builtin_amdgcn_global_load_lds((const unsigned*)((const char*)(gbase) + (voff)[_i]), (LAS unsigned*)(lds + (bufoff) + ldsw + _i * 8192), 16, 0, 0); } while (0)
#define PG8_LDA(dst, b, h) do { _Pragma("unroll") for (int m = 0; m < 4; ++m) _Pragma("unroll") for (int k = 0; k < 2; ++k) dst[m][k] = *(const LAS bf16x8*)(lds + PG8_SA(b, h) + aoff + m * 2048 + k * 1024); } while (0)
#define PG8_LDB(dst, b, h) do { _Pragma("unroll") for (int n = 0; n < 2; ++n) _Pragma("unroll") for (int k = 0; k < 2; ++k) dst[n][k] = *(const LAS bf16x8*)(lds + PG8_SB(b, h) + boff + n * 2048 + k * 1024); } while (0)
#define PG8_MMA(ai, bj, At, Bt) do { __builtin_amdgcn_s_setprio(1); _Pragma("unroll") for (int m = 0; m < 4; ++m) _Pragma("unroll") for (int n = 0; n < 2; ++n) _Pragma("unroll") for (int k = 0; k < 2; ++k) \
    acc[ai][bj][m][n] = __builtin_amdgcn_mfma_f32_16x16x32_bf16(Bt[n][k], At[m][k], acc[ai][bj][m][n], 0, 0, 0); __builtin_amdgcn_s_setprio(0); } while (0)
#define PG8_WAIT_V(n) asm volatile("s_waitcnt vmcnt(" #n ")" ::: "memory")
#define PG8_WAIT_L(n) asm volatile("s_waitcnt lgkmcnt(" #n ")" ::: "memory")
#define PG8_BAR __builtin_amdgcn_s_barrier()
#define PG8_SCHED __builtin_amdgcn_sched_barrier(0)
  Unit cur, nxt; int ui = 0;
  if (!S.next(0, cur)) return;
  f32x4 acc[2][2][4][2];
#pragma unroll
  for (int a = 0; a < 2; ++a)
#pragma unroll
    for (int b = 0; b < 2; ++b)
#pragma unroll
      for (int m = 0; m < 4; ++m)
#pragma unroll
        for (int n = 0; n < 2; ++n) acc[a][b][m][n] = (f32x4){0.f, 0.f, 0.f, 0.f};
  bf16x8 At[4][2], B0[2][2], B1[2][2];
  const char* cA = (const char*)g.A + (size_t)cur.pm * tstepA; const char* cB = (const char*)g.Bt + (size_t)cur.pn * tstepB;
  PG8_STAGE(PG8_SB(0, 0), cB, voffB); PG8_STAGE(PG8_SA(0, 0), cA, voffA); PG8_STAGE(PG8_SB(0, 1), cB + hstepB, voffB); PG8_STAGE(PG8_SA(0, 1), cA + hstepA, voffA);
  if (wr == 1) PG8_BAR;
  PG8_WAIT_V(4); PG8_BAR;
  PG8_STAGE(PG8_SB(1, 0), cB + kstep, voffB); PG8_STAGE(PG8_SA(1, 0), cA + kstep, voffA); PG8_STAGE(PG8_SB(1, 1), cB + hstepB + kstep, voffB);
  PG8_WAIT_V(6); PG8_BAR;
  for (;;) {
    const bool has_next = S.next(ui + 1, nxt);
    const char* nA = has_next ? (const char*)g.A + (size_t)nxt.pm * tstepA : cA; const char* nB = has_next ? (const char*)g.Bt + (size_t)nxt.pn * tstepB : cB;
    for (int t = 0; t < nt; t += 2) {
      const bool last = (t == nt - 2);
      const char* a1 = cA + (size_t)(t + 1) * kstep;
      const char* a2 = last ? nA : cA + (size_t)(t + 2) * kstep; const char* b2 = last ? nB : cB + (size_t)(t + 2) * kstep;
      const char* a3 = a2 + kstep; const char* b3 = b2 + kstep;
      PG8_LDB(B0, 0, 0); PG8_SCHED; PG8_LDA(At, 0, 0); PG8_STAGE(PG8_SA(1, 1), a1 + hstepA, voffA);
      PG8_WAIT_L(8); PG8_BAR; PG8_WAIT_L(0); PG8_MMA(0, 0, At, B0); PG8_BAR; PG8_SCHED;
      PG8_LDB(B1, 0, 1); PG8_STAGE(PG8_SB(0, 0), b2, voffB);
      PG8_BAR; PG8_WAIT_L(0); PG8_MMA(0, 1, At, B1); PG8_BAR;
      PG8_LDA(At, 0, 1); PG8_STAGE(PG8_SA(0, 0), a2, voffA);
      PG8_BAR; PG8_WAIT_L(0); PG8_MMA(1, 0, At, B0); PG8_BAR; PG8_SCHED;
      PG8_STAGE(PG8_SB(0, 1), b2 + hstepB, voffB);
      PG8_WAIT_V(6); PG8_BAR; PG8_MMA(1, 1, At, B1); PG8_BAR;
      PG8_LDB(B0, 1, 0); PG8_SCHED; PG8_LDA(At, 1, 0); PG8_STAGE(PG8_SA(0, 1), a2 + hstepA, voffA);
      PG8_WAIT_L(8); PG8_BAR; PG8_WAIT_L(0); PG8_MMA(0, 0, At, B0); PG8_BAR; PG8_SCHED;
      PG8_LDB(B1, 1, 1); PG8_STAGE(PG8_SB(1, 0), b3, voffB);
      PG8_BAR; PG8_WAIT_L(0); PG8_MMA(0, 1, At, B1); PG8_BAR;
      PG8_LDA(At, 1, 1); PG8_STAGE(PG8_SA(1, 0), a3, voffA);
      PG8_BAR; PG8_WAIT_L(0); PG8_MMA(1, 0, At, B0); PG8_BAR; PG8_SCHED;
      PG8_STAGE(PG8_SB(1, 1), b3 + hstepB, voffB);
      PG8_WAIT_V(6); PG8_BAR; PG8_MMA(1, 1, At, B1); PG8_BAR;
    }
    E(acc, cur, wr, wc, fr, fq);
    if (!has_next) break;
#pragma unroll
    for (int a = 0; a < 2; ++a)
#pragma unroll
      for (int b = 0; b < 2; ++b)
#pragma unroll
        for (int m = 0; m < 4; ++m)
#pragma unroll
          for (int n = 0; n < 2; ++n) acc[a][b][m][n] = (f32x4){0.f, 0.f, 0.f, 0.f};
    cur = nxt; cA = nA; cB = nB; ++ui;
  }
  PG8_WAIT_V(0);
  if (wr == 0) PG8_BAR;
  PG8_BAR;
#undef PG8_SA
#undef PG8_SB
#undef PG8_STAGE
#undef PG8_LDA
#undef PG8_LDB
#undef PG8_MMA
#undef PG8_WAIT_V
#undef PG8_WAIT_L
#undef PG8_BAR
#undef PG8_SCHED
}


template <class Epi>
__device__ __forceinline__ void gemm_phase_seg(LAS unsigned char* lds, const bf16_t* A0, const bf16_t* A1, const bf16_t* A2,
                                               const bf16_t* Bt0, const bf16_t* Bt1, const bf16_t* Bt2, int K0, int K12, const StaticOrder& S, const Epi& E) {
  int tid = threadIdx.x; asm volatile("" : "+v"(tid));
  const int wid = __builtin_amdgcn_readfirstlane(tid >> 6), lane = tid & 63, wr = wid >> 2, wc = wid & 3, fr = lane & 15, fq = lane >> 4;
  unsigned Rv[2], C2[2];
#pragma unroll
  for (int i = 0; i < 2; ++i) { int R, C; stage_rc(tid * 16 + i * 8192, R, C); Rv[i] = (unsigned)R; C2[i] = (unsigned)C * 2u; }
  asm volatile("" : "+v"(Rv[0]), "+v"(Rv[1]), "+v"(C2[0]), "+v"(C2[1]));
  const size_t kstep = (size_t)(BK * 2);
  const unsigned ldsw = (unsigned)wid * 1024u;
  const int aoff = lds_byte(wr * 64 + fr, fq * 8), boff = lds_byte(wc * 32 + fr, fq * 8);
#define PG8_SA(b, h) (((b) * 2 + (h)) * HTB)
#define PG8_SB(b, h) ((4 + (b) * 2 + (h)) * HTB)
#define PG8_STAGE(bufoff, gbase, ld2) do { _Pragma("unroll") for (int _i = 0; _i < 2; ++_i) \
    __builtin_amdgcn_global_load_lds((const unsigned*)((const char*)(gbase) + (Rv[_i] * (unsigned)(ld2) + C2[_i])), (LAS unsigned*)(lds + (bufoff) + ldsw + _i * 8192), 16, 0, 0); } while (0)
#define PG8_LDA(dst, b, h) do { _Pragma("unroll") for (int m = 0; m < 4; ++m) _Pragma("unroll") for (int k = 0; k < 2; ++k) dst[m][k] = *(const LAS bf16x8*)(lds + PG8_SA(b, h) + aoff + m * 2048 + k * 1024); } while (0)
#define PG8_LDB(dst, b, h) do { _Pragma("unroll") for (int n = 0; n < 2; ++n) _Pragma("unroll") for (int k = 0; k < 2; ++k) dst[n][k] = *(const LAS bf16x8*)(lds + PG8_SB(b, h) + boff + n * 2048 + k * 1024); } while (0)
#define PG8_MMA(ai, bj, At, Bt) do { __builtin_amdgcn_s_setprio(1); _Pragma("unroll") for (int m = 0; m < 4; ++m) _Pragma("unroll") for (int n = 0; n < 2; ++n) _Pragma("unroll") for (int k = 0; k < 2; ++k) \
    acc[ai][bj][m][n] = __builtin_amdgcn_mfma_f32_16x16x32_bf16(Bt[n][k], At[m][k], acc[ai][bj][m][n], 0, 0, 0); __builtin_amdgcn_s_setprio(0); } while (0)
#define PG8_WAIT_V(n) asm volatile("s_waitcnt vmcnt(" #n ")" ::: "memory")
#define PG8_WAIT_L(n) asm volatile("s_waitcnt lgkmcnt(" #n ")" ::: "memory")
#define PG8_BAR __builtin_amdgcn_s_barrier()
#define PG8_SCHED __builtin_amdgcn_sched_barrier(0)
  Unit cur, nxt; int ui = 0; int cseg = 0;
  if (!S.next(0, cur)) return;
  f32x4 acc[2][2][4][2];
#pragma unroll
  for (int a = 0; a < 2; ++a)
#pragma unroll
    for (int b = 0; b < 2; ++b)
#pragma unroll
      for (int m = 0; m < 4; ++m)
#pragma unroll
        for (int n = 0; n < 2; ++n) acc[a][b][m][n] = (f32x4){0.f, 0.f, 0.f, 0.f};
  bf16x8 At[4][2], B0[2][2], B1[2][2];
  int cK = K0;
  unsigned ld2 = (unsigned)cK * 2u;
  size_t hstep = (size_t)HALF * ld2;
  const char* cA = (const char*)A0 + (size_t)cur.pm * 2 * hstep; const char* cB = (const char*)Bt0 + (size_t)cur.pn * 2 * hstep;
  PG8_STAGE(PG8_SB(0, 0), cB, ld2); PG8_STAGE(PG8_SA(0, 0), cA, ld2); PG8_STAGE(PG8_SB(0, 1), cB + hstep, ld2); PG8_STAGE(PG8_SA(0, 1), cA + hstep, ld2);
  if (wr == 1) PG8_BAR;
  PG8_WAIT_V(4); PG8_BAR;
  PG8_STAGE(PG8_SB(1, 0), cB + kstep, ld2); PG8_STAGE(PG8_SA(1, 0), cA + kstep, ld2); PG8_STAGE(PG8_SB(1, 1), cB + hstep + kstep, ld2);
  PG8_WAIT_V(6); PG8_BAR;
  for (;;) {
    int nseg = cseg + 1; bool has_next = true; nxt = cur;
    if (nseg == 3) { nseg = 0; has_next = S.next(ui + 1, nxt); }
    const int nK = has_next ? (nseg == 0 ? K0 : K12) : cK;
    const unsigned nld2 = (unsigned)nK * 2u;
    const size_t nhstep = (size_t)HALF * nld2;
    const bf16_t* nAb = nseg == 0 ? A0 : (nseg == 1 ? A1 : A2);
    const bf16_t* nBb = nseg == 0 ? Bt0 : (nseg == 1 ? Bt1 : Bt2);
    const char* nA = has_next ? (const char*)nAb + (size_t)nxt.pm * 2 * nhstep : cA;
    const char* nB = has_next ? (const char*)nBb + (size_t)nxt.pn * 2 * nhstep : cB;
    const int nt = cK / BK;
    for (int t = 0; t < nt; t += 2) {
      const bool last = (t == nt - 2);
      const char* a1 = cA + (size_t)(t + 1) * kstep;
      const char* a2 = last ? nA : cA + (size_t)(t + 2) * kstep; const char* b2 = last ? nB : cB + (size_t)(t + 2) * kstep;
      const char* a3 = a2 + kstep; const char* b3 = b2 + kstep;
      const unsigned l2 = last ? nld2 : ld2; const size_t h2 = last ? nhstep : hstep;
      PG8_LDB(B0, 0, 0); PG8_SCHED; PG8_LDA(At, 0, 0); PG8_STAGE(PG8_SA(1, 1), a1 + hstep, ld2);
      PG8_WAIT_L(8); PG8_BAR; PG8_WAIT_L(0); PG8_MMA(0, 0, At, B0); PG8_BAR; PG8_SCHED;
      PG8_LDB(B1, 0, 1); PG8_STAGE(PG8_SB(0, 0), b2, l2);
      PG8_BAR; PG8_WAIT_L(0); PG8_MMA(0, 1, At, B1); PG8_BAR;
      PG8_LDA(At, 0, 1); PG8_STAGE(PG8_SA(0, 0), a2, l2);
      PG8_BAR; PG8_WAIT_L(0); PG8_MMA(1, 0, At, B0); PG8_BAR; PG8_SCHED;
      PG8_STAGE(PG8_SB(0, 1), b2 + h2, l2);
      PG8_WAIT_V(6); PG8_BAR; PG8_MMA(1, 1, At, B1); PG8_BAR;
      PG8_LDB(B0, 1, 0); PG8_SCHED; PG8_LDA(At, 1, 0); PG8_STAGE(PG8_SA(0, 1), a2 + h2, l2);
      PG8_WAIT_L(8); PG8_BAR; PG8_WAIT_L(0); PG8_MMA(0, 0, At, B0); PG8_BAR; PG8_SCHED;
      PG8_LDB(B1, 1, 1); PG8_STAGE(PG8_SB(1, 0), b3, l2);
      PG8_BAR; PG8_WAIT_L(0); PG8_MMA(0, 1, At, B1); PG8_BAR;
      PG8_LDA(At, 1, 1); PG8_STAGE(PG8_SA(1, 0), a3, l2);
      PG8_BAR; PG8_WAIT_L(0); PG8_MMA(1, 0, At, B0); PG8_BAR; PG8_SCHED;
      PG8_STAGE(PG8_SB(1, 1), b3 + h2, l2);
      PG8_WAIT_V(6); PG8_BAR; PG8_MMA(1, 1, At, B1); PG8_BAR;
    }
    E(acc, cur, cseg, wr, wc, fr, fq);
    if (!has_next) break;
    if (nseg == 0) {
#pragma unroll
      for (int a = 0; a < 2; ++a)
#pragma unroll
        for (int b = 0; b < 2; ++b)
#pragma unroll
          for (int m = 0; m < 4; ++m)
#pragma unroll
            for (int n = 0; n < 2; ++n) acc[a][b][m][n] = (f32x4){0.f, 0.f, 0.f, 0.f};
      ++ui;
    }
    cur = nxt; cA = nA; cB = nB; cseg = nseg; cK = nK; ld2 = nld2; hstep = nhstep;
  }
  PG8_WAIT_V(0);
  if (wr == 0) PG8_BAR;
  PG8_BAR;
#undef PG8_SA
#undef PG8_SB
#undef PG8_STAGE
#undef PG8_LDA
#undef PG8_LDB
#undef PG8_MMA
#undef PG8_WAIT_V
#undef PG8_WAIT_L
#undef PG8_BAR
#undef PG8_SCHED
}

template <class FL, class FA> struct EpiSeg {
  FL ld; FA ap;
  __device__ __forceinline__ void operator()(f32x4 (&acc)[2][2][4][2], const Unit& u, int seg, int wr, int wc, int fr, int fq) const {
    asm volatile("" : "+v"(fr), "+v"(fq));
    uint2 g[2][4][2][2];
#pragma unroll
    for (int ai = 0; ai < 2; ++ai)
#pragma unroll
      for (int m = 0; m < 4; ++m) {
        const int row = u.pm * BM + ai * HALF + wr * 64 + m * 16 + fr;
#pragma unroll
        for (int bj = 0; bj < 2; ++bj)
#pragma unroll
          for (int n = 0; n < 2; ++n) g[ai][m][bj][n] = ld(row, u.pn * BM + bj * HALF + wc * 32 + n * 16 + 4 * fq, seg);
      }
#pragma unroll
    for (int ai = 0; ai < 2; ++ai)
#pragma unroll
      for (int m = 0; m < 4; ++m) {
        const int row = u.pm * BM + ai * HALF + wr * 64 + m * 16 + fr;
#pragma unroll
        for (int bj = 0; bj < 2; ++bj)
#pragma unroll
          for (int n = 0; n < 2; ++n) ap(row, u.pn * BM + bj * HALF + wc * 32 + n * 16 + 4 * fq, acc[ai][bj][m][n], seg, g[ai][m][bj][n]);
      }
  }
};
template <class FL, class FA> __device__ __forceinline__ EpiSeg<FL, FA> make_epi_seg(FL l, FA a) { return EpiSeg<FL, FA>{l, a}; }

template <class F> struct EpiL {
  F f;
  __device__ __forceinline__ void operator()(const f32x4 (&acc)[2][2][4][2], const Unit& u, int wr, int wc, int fr, int fq) const {
    asm volatile("" : "+v"(fr), "+v"(fq));
#pragma unroll
    for (int ai = 0; ai < 2; ++ai)
#pragma unroll
      for (int m = 0; m < 4; ++m) {
        const int row = u.pm * BM + ai * HALF + wr * 64 + m * 16 + fr;
#pragma unroll
        for (int bj = 0; bj < 2; ++bj)
#pragma unroll
          for (int n = 0; n < 2; ++n) f(row, u.pn * BM + bj * HALF + wc * 32 + n * 16 + 4 * fq, acc[ai][bj][m][n]);
        asm volatile("" ::: "memory");
      }
  }
};
template <class F> __device__ __forceinline__ EpiL<F> make_epi(F f) { return EpiL<F>{f}; }
}

template <class F>
__device__ __forceinline__ void run_gemm(LAS unsigned char* lds, const bf16_t* A, int lda, const bf16_t* Bt, int ldb, int N, int K, F f, int boff = 0) {
  asm volatile("" : "+s"(K), "+s"(lda), "+s"(ldb));
  pg8::StaticOrder S; S.init(16384, N, gridDim.x, (int)((blockIdx.x + (unsigned)boff) % gridDim.x));
  pg8::Gemm g{A, Bt, lda, ldb, K};
  pg8::gemm_phase(lds, g, S, pg8::make_epi(f));
}

__device__ __forceinline__ void transpose_tile(const float* __restrict__ src, int lds_, bf16_t* __restrict__ dst, int ldd, float* tile, int tid) {
#pragma unroll
  for (int i = 0; i < 2; ++i) {
    int idx = tid + i * 512;
    int r = idx >> 4, c4 = (idx & 15) * 4;
    float4 v = ld_nt4(src + (size_t)r * lds_ + c4);
    *(float4*)(tile + r * 68 + c4) = v;
  }
  __syncthreads();
  {
    int n = tid & 63, k0 = (tid >> 6) * 8;
    const float* tp = tile + k0 * 68 + n;
    uint4 o;
    o.x = pack2(tp[0], tp[68]); o.y = pack2(tp[136], tp[204]); o.z = pack2(tp[272], tp[340]); o.w = pack2(tp[408], tp[476]);
    *(uint4*)(dst + (size_t)n * ldd + k0) = o;
  }
  __syncthreads();
}

__device__ __forceinline__ void convert_layer(const Params& p, int l, float* tile, int tid) {
  asm volatile("" : "+v"(tid));
  bf16_t* WT = (bf16_t*)(p.ws + WS_WT);
  bf16_t* VCT = (bf16_t*)(p.ws + WS_UB + UB_VCT);
  bf16_t* KC = (bf16_t*)(p.ws + WS_UB + UB_KC);
  for (int ti0 = blockIdx.x; ti0 < 4496; ti0 += gridDim.x) {
    int ti = ti0;
    const float* src; int lds_; bf16_t* dst; int ldd;
    if (ti < 1344) {
      int kt = ti / 84, nt = ti % 84;
      src = p.w_in + (size_t)l * 1024 * 5376 + (size_t)kt * 64 * 5376 + nt * 64; lds_ = 5376;
      int nrow = nt * 64; nrow = nrow < 2048 ? nrow : (nrow < 2304 ? nrow + 3072 : nrow - 256);
      dst = WT + WT_IN + (size_t)nrow * 1024 + kt * 64; ldd = 1024;
    } else if ((ti -= 1344) < 128) {
      int kt = ti / 16, nt = ti % 16;
      src = p.w_br_attn + (size_t)l * 512 * 1024 + (size_t)kt * 64 * 1024 + nt * 64; lds_ = 1024;
      dst = WT + WT_BRA + (size_t)nt * 64 * 512 + kt * 64; ldd = 512;
    } else if ((ti -= 128) < 64) {
      int kt = ti / 16, nt = ti % 16;
      src = p.w_br_s5 + (size_t)l * 256 * 1024 + (size_t)kt * 64 * 1024 + nt * 64; lds_ = 1024;
      dst = WT + WT_BRS + (size_t)nt * 64 * 256 + kt * 64; ldd = 256;
    } else if ((ti -= 64) < 64) {
      int kt = ti / 16, nt = ti % 16;
      src = p.w_br_lru + (size_t)l * 256 * 1024 + (size_t)kt * 64 * 1024 + nt * 64; lds_ = 1024;
      dst = WT + WT_BRL + (size_t)nt * 64 * 256 + kt * 64; ldd = 256;
    } else if ((ti -= 64) < 256) {
      int kt = ti / 16, nt = ti % 16;
      src = p.w_out + (size_t)l * 1024 * 1024 + (size_t)kt * 64 * 1024 + nt * 64; lds_ = 1024;
      dst = WT + WT_OUT + (size_t)nt * 64 * 1024 + kt * 64; ldd = 1024;
    } else if ((ti -= 256) < 1408) {
      int kt = ti / 88, nt = ti % 88;
      src = p.ffn_w_up + (size_t)l * 1024 * 5632 + (size_t)kt * 64 * 5632 + nt * 64; lds_ = 5632;
      dst = WT + WT_UP + (size_t)nt * 64 * 1024 + kt * 64; ldd = 1024;
    } else if ((ti -= 1408) < 704) {
      int kt = ti / 16, nt = ti % 16;
      src = p.ffn_w_down + (size_t)l * 2816 * 1024 + (size_t)kt * 64 * 1024 + nt * 64; lds_ = 1024;
      dst = WT + WT_DOWN + (size_t)nt * 64 * 2816 + kt * 64; ldd = 2816;
    } else if ((ti -= 704) < 16) {
      int kt = ti / 4, nt = ti % 4;
      src = p.s5_w_glu + (size_t)l * 65536 + (size_t)kt * 64 * 256 + nt * 64; lds_ = 256;
      dst = WT + WT_GLU + (size_t)nt * 64 * 256 + kt * 64; ldd = 256;
    } else {
      ti -= 16;
      int ct = ti & 7, h = (ti >> 3) & 7, b = ti >> 6;
      src = p.cache_v + ((size_t)(b * 2 + l) * 512 + ct * 64) * 512 + h * 64; lds_ = 512;
      dst = VCT + (size_t)((b * 8 + h) * 64) * 512 + ct * 64; ldd = 512;
    }
    transpose_tile(src, lds_, dst, ldd, tile, tid);
  }
  for (int idx = blockIdx.x * 512 + tid; idx < 262144; idx += gridDim.x * 512) {
    int d8 = idx & 7, h = (idx >> 3) & 7, c = (idx >> 6) & 511, b = idx >> 15;
    const float* s = p.cache_k + ((size_t)((b * 2 + l) * 512 + c) * 8 + h) * 64 + d8 * 8;
    float4 v0 = ld_nt4(s), v1 = ld_nt4(s + 4);
    uint4 o;
    o.x = pack2(v0.x, v0.y); o.y = pack2(v0.z, v0.w); o.z = pack2(v1.x, v1.y); o.w = pack2(v1.z, v1.w);
    *(uint4*)(KC + ((size_t)((b * 8 + h) * 512 + c)) * 64 + d8 * 8) = o;
  }
  for (int idx = blockIdx.x * 512 + tid; idx < 262144; idx += gridDim.x * 512) {
    int n = idx >> 8, k = idx & 255;
    int dir = n >> 9, gate = (n >> 8) & 1, ch = n & 255;
    int blk = ch >> 6, j = ch & 63, kb = k >> 6, i = k & 63;
    float v = 0.f;
    if (kb == blk) v = (gate ? p.lru_w_x : p.lru_w_a)[(size_t)l * 32768 + ((size_t)(dir * 4 + blk) * 64 + i) * 64 + j];
    WT[WT_LRU + idx] = f2bf(v);
  }
}

__device__ __forceinline__ void norm_phase(const Params& p, int l, int which, bool from_inputs, int tid) {
  float* X = p.out;
  const float* MOD = (const float*)(p.ws + WS_MOD) + (size_t)l * 9 * 6144;
  bf16_t* H = (bf16_t*)(p.ws + WS_HBUF);
  const float* g = (which == 0 ? p.g1 : p.g2) + l * 1024;
  const int shoff = which == 0 ? 0 : 3072, scoff = which == 0 ? 1024 : 4096;
  asm volatile("" : "+v"(tid));
  const int lane = tid & 63, wave = tid >> 6;
  for (int r = blockIdx.x * 8 + wave; r < 16384; r += gridDim.x * 8) {
    const float* xr = from_inputs ? (r < 8192 ? p.x_prompt + (size_t)r * 1024 : p.x_sample + (size_t)(r - 8192) * 1024)
                                  : X + (size_t)r * 1024;
    float4 v[4];
    float ss = 0.f;
#pragma unroll
    for (int i = 0; i < 4; ++i) {
      v[i] = *(const float4*)(xr + i * 256 + lane * 4);
      ss += v[i].x * v[i].x + v[i].y * v[i].y + v[i].z * v[i].z + v[i].w * v[i].w;
    }
#pragma unroll
    for (int o = 32; o >= 1; o >>= 1) ss += __shfl_xor(ss, o);
    float rstd = rsqrtf(ss * (1.f / 1024.f) + 1e-6f);
    const float* mr = MOD + (size_t)modrow(r) * 6144;
#pragma unroll
    for (int i = 0; i < 4; ++i) {
      int c = i * 256 + lane * 4;
      float4 gg = *(const float4*)(g + c);
      float4 sc = *(const float4*)(mr + scoff + c);
      float4 sh = *(const float4*)(mr + shoff + c);
      float o0 = v[i].x * rstd * gg.x * (1.f + sc.x) + sh.x;
      float o1 = v[i].y * rstd * gg.y * (1.f + sc.y) + sh.y;
      float o2 = v[i].z * rstd * gg.z * (1.f + sc.z) + sh.z;
      float o3 = v[i].w * rstd * gg.w * (1.f + sc.w) + sh.w;
      uint2 o; o.x = pack2(o0, o1); o.y = pack2(o2, o3);
      *(uint2*)(H + (size_t)r * 1024 + c) = o;
    }
  }
}

struct AttnState {
  f32x4 o[4];
  float m, lsum;
};

__device__ __forceinline__ void attn_scores(const bf16_t* kb, int kld, const bf16x8 (&qf)[2], float (&s)[8], int l15, int quad) {
#pragma unroll
  for (int half = 0; half < 2; ++half) {
    const bf16_t* kp = kb + (size_t)(half * 16 + l15) * kld + quad * 8;
    bf16x8 a0 = *(const bf16x8*)kp;
    bf16x8 a1 = *(const bf16x8*)(kp + 32);
    f32x4 acc = {0.f, 0.f, 0.f, 0.f};
    acc = __builtin_amdgcn_mfma_f32_16x16x32_bf16(a0, qf[0], acc, 0, 0, 0);
    acc = __builtin_amdgcn_mfma_f32_16x16x32_bf16(a1, qf[1], acc, 0, 0, 0);
#pragma unroll
    for (int e = 0; e < 4; ++e) s[half * 4 + e] = acc[e];
  }
}

__device__ __forceinline__ void attn_update(AttnState& st, float (&s)[8], const bf16_t* vt, int vtld, int l15, int quad) {
  float tm = s[0];
#pragma unroll
  for (int i = 1; i < 8; ++i) tm = fmaxf(tm, s[i]);
  tm = fmaxf(tm, __shfl_xor(tm, 16));
  tm = fmaxf(tm, __shfl_xor(tm, 32));
  float mn = fmaxf(st.m, tm);
  float alpha = __expf(st.m - mn);
  st.m = mn;
  float pv[8];
  float ps = 0.f;
#pragma unroll
  for (int i = 0; i < 8; ++i) { pv[i] = __expf(s[i] - mn); ps += pv[i]; }
  st.lsum = st.lsum * alpha + ps;
  union { uint4 u; bf16x8 v; } pb;
  pb.u.x = pack2(pv[0], pv[1]); pb.u.y = pack2(pv[2], pv[3]); pb.u.z = pack2(pv[4], pv[5]); pb.u.w = pack2(pv[6], pv[7]);
#pragma unroll
  for (int db = 0; db < 4; ++db) {
    const bf16_t* vp = vt + (size_t)(db * 16 + l15) * vtld + quad * 4;
    uint2 lo = *(const uint2*)vp;
    uint2 hi = *(const uint2*)(vp + 16);
    union { uint4 u; bf16x8 v; } va;
    va.u.x = lo.x; va.u.y = lo.y; va.u.z = hi.x; va.u.w = hi.y;
    f32x4 o = st.o[db];
    o[0] *= alpha; o[1] *= alpha; o[2] *= alpha; o[3] *= alpha;
    st.o[db] = __builtin_amdgcn_mfma_f32_16x16x32_bf16(va.v, pb.v, o, 0, 0, 0);
  }
}

__device__ __forceinline__ void s5_disc(const Params& p, int l, int dir, int g, int n, float& lbr, float& lbi, float& cr, float& ci) {
  int li = ((l * 2 + dir) * 16 + g) * 64 + n;
  float lre = p.s5_lam_re[li], lim = p.s5_lam_im[li];
  float stp = expf(p.s5_log_step[(l * 2 + dir) * 16 + g]);
  float er = expf(lre * stp);
  float ang = lim * stp;
  lbr = er * cosf(ang); lbi = er * sinf(ang);
  float nr = lbr - 1.f, ni = lbi;
  float den = lre * lre + lim * lim;
  cr = (nr * lre + ni * lim) / den;
  ci = (ni * lre - nr * lim) / den;
}

#define S5_BUS 132
#define S5_HS 136
#define S5_WAVE_BYTES 12800

__global__ void __launch_bounds__(512, 2) mega(Params p) {
  cg::grid_group grid = cg::this_grid();
  extern __shared__ __attribute__((aligned(16))) unsigned char dyn_lds[];
  LAS unsigned char* lds = (LAS unsigned char*)dyn_lds;
  char* smem_raw = (char*)dyn_lds;
  const int tid = threadIdx.x;
  const int lane = tid & 63, wave = tid >> 6;
  const int l15 = lane & 15, quad = lane >> 4;

  volatile LAS unsigned* xb_st = (volatile LAS unsigned*)(lds + 132096);
  if (tid == 0) { xb_st[0] = 0u; xb_st[1] = 0u; }
  __syncthreads();
  unsigned* const BAR = (unsigned*)(p.ws + WS_BAR);
  const XcdBarrier xb = xcd_barrier_post(BAR, xb_st);

  char* const WSB = p.ws;
  float* const OUTB = p.out;
#define X OUTB
#define MODALL ((float*)(WSB + WS_MOD))
#define WT ((bf16_t*)(WSB + WS_WT))
#define HBUF ((bf16_t*)(WSB + WS_HBUF))
#define UB (WSB + WS_UB)
#define QB ((bf16_t*)(WSB + WS_UB + UB_QB))
#define KB ((bf16_t*)(WSB + WS_UB + UB_KB))
#define VTC ((bf16_t*)(WSB + WS_UB + UB_VTC))
#define VTL ((bf16_t*)(WSB + WS_UB + UB_VTL))
#define U ((bf16_t*)(WSB + WS_UB + UB_U))
#define XR ((bf16_t*)(WSB + WS_UB + UB_XR))
#define XG ((bf16_t*)(WSB + WS_UB + UB_XG))
#define S5Y ((bf16_t*)(WSB + WS_UB + UB_S5Y))
#define LRUY ((bf16_t*)(WSB + WS_UB + UB_LRUY))
#define MG ((bf16_t*)(WSB + WS_UB + UB_MG))
#define KC ((bf16_t*)(WSB + WS_UB + UB_KC))
#define VCT ((bf16_t*)(WSB + WS_UB + UB_VCT))
#define G8 ((unsigned char*)(WSB + WS_UB + UB_G8))

  {
    float* sc = (float*)smem_raw;
    float* red = sc + 9 * 1024;
    if (blockIdx.x < 384) {
      for (int i = tid; i < 9 * 1024; i += 512) {
        int m = i >> 10, k = i & 1023;
        float v = (m == 0) ? p.c_ctx[k] : p.c[(m - 1) * 1024 + k];
        sc[i] = v / (1.f + __expf(-v));
      }
      __syncthreads();
      for (int item = blockIdx.x; item < 384; item += gridDim.x) {
        int l = item / 192, n0 = (item % 192) * 32;
        int cs_ = tid & 31, ks = tid >> 5;
        float a0 = 0, a1 = 0, a2 = 0, a3 = 0, a4 = 0, a5 = 0, a6 = 0, a7 = 0, a8 = 0;
        const float* w = p.w_ada + (size_t)l * 1024 * 6144 + (size_t)(ks * 64) * 6144 + n0 + cs_;
        const float* s0 = sc + ks * 64;
#pragma unroll 8
        for (int k = 0; k < 64; ++k) {
          float wv = __builtin_nontemporal_load(w + (size_t)k * 6144);
          a0 += s0[k] * wv; a1 += s0[1024 + k] * wv; a2 += s0[2048 + k] * wv; a3 += s0[3072 + k] * wv;
          a4 += s0[4096 + k] * wv; a5 += s0[5120 + k] * wv; a6 += s0[6144 + k] * wv; a7 += s0[7168 + k] * wv;
          a8 += s0[8192 + k] * wv;
        }
        red[(ks * 9 + 0) * 32 + cs_] = a0; red[(ks * 9 + 1) * 32 + cs_] = a1; red[(ks * 9 + 2) * 32 + cs_] = a2;
        red[(ks * 9 + 3) * 32 + cs_] = a3; red[(ks * 9 + 4) * 32 + cs_] = a4; red[(ks * 9 + 5) * 32 + cs_] = a5;
        red[(ks * 9 + 6) * 32 + cs_] = a6; red[(ks * 9 + 7) * 32 + cs_] = a7; red[(ks * 9 + 8) * 32 + cs_] = a8;
        __syncthreads();
        if (tid < 288) {
          int m = tid >> 5, c = tid & 31;
          float s = 0.f;
#pragma unroll
          for (int k2 = 0; k2 < 16; ++k2) s += red[(k2 * 9 + m) * 32 + c];
          MODALL[(size_t)(l * 9 + m) * 6144 + n0 + c] = s + p.b_ada[l * 6144 + n0 + c];
        }
        __syncthreads();
      }
    }
    __syncthreads();
    PH(11) convert_layer(p, 0, (float*)smem_raw, tid);
  }
  grid.sync();

  for (int l = 0; l < 2; ++l) {
    const float* MOD = MODALL + (size_t)l * 9 * 6144;
    if (l == 1) PH(11) convert_layer(p, 1, (float*)smem_raw, tid);
    PH(12) norm_phase(p, l, 0, l == 0, tid);
    GSYNC();

    float* const OUTP = p.out;
    PH(1) run_gemm(lds, HBUF, 1024, WT + WT_IN, 1024, 5120, 1024, [=](int row, int col, f32x4 v) {
      if (col < 512) {
        const float qs = 0.125f * 1.4426950408889634f;
        uint2 o; o.x = pack2(v[0] * qs, v[1] * qs); o.y = pack2(v[2] * qs, v[3] * qs);
        *(uint2*)(QB + (size_t)row * 512 + col) = o;
      } else if (col < 1024) {
        uint2 o; o.x = pack2(v[0], v[1]); o.y = pack2(v[2], v[3]);
        *(uint2*)(KB + (size_t)row * 512 + col - 512) = o;
        if (row < 8192) {
          int b = row >> 8, t = row & 255;
          *(f32x4*)(OUTP + OUT_NEWK + ((size_t)((b * 2 + l) * 256 + t)) * 512 + (col - 512)) = v;
        }
      } else if (col < 1536) {
        int c = col - 1024, h = c >> 6, d = c & 63;
        if (row < 8192) {
          int b = row >> 8, t = row & 255;
          bf16_t* vp = VTC + ((size_t)((b * 8 + h) * 64 + d)) * 256 + t;
          vp[0] = f2bf(v[0]); vp[256] = f2bf(v[1]); vp[512] = f2bf(v[2]); vp[768] = f2bf(v[3]);
          *(f32x4*)(OUTP + OUT_NEWV + ((size_t)((b * 2 + l) * 256 + t)) * 512 + c) = v;
        } else {
          int b = (row - 8192) >> 10, t = (row - 8192) & 1023;
          bf16_t* vp = VTL + ((size_t)((b * 8 + h) * 64 + d)) * 1024 + t;
          vp[0] = f2bf(v[0]); vp[1024] = f2bf(v[1]); vp[2048] = f2bf(v[2]); vp[3072] = f2bf(v[3]);
        }
      } else if (col < 2048) {
        uint2 o; o.x = pack2(v[0], v[1]); o.y = pack2(v[2], v[3]);
        bf16_t* dst = col < 1792 ? U + (size_t)row * 256 + (col - 1536) : XR + (size_t)row * 256 + (col - 1792);
        *(uint2*)dst = o;
      } else {
        uint32_t q0 = (uint32_t)(sigmoidf_(v[0]) * 255.f + 0.5f), q1 = (uint32_t)(sigmoidf_(v[1]) * 255.f + 0.5f);
        uint32_t q2 = (uint32_t)(sigmoidf_(v[2]) * 255.f + 0.5f), q3 = (uint32_t)(sigmoidf_(v[3]) * 255.f + 0.5f);
        *(uint32_t*)(G8 + (size_t)row * 3072 + (col - 2048)) = q0 | (q1 << 8) | (q2 << 16) | (q3 << 24);
      }
    });
    GSYNC();

    PH(15) run_gemm(lds, HBUF, 1024, WT + WT_IN + (size_t)5120 * 1024, 1024, 256, 1024, [=](int row, int col, f32x4 v) {
      uint2 o; o.x = pack2(v[0], v[1]); o.y = pack2(v[2], v[3]);
      *(uint2*)(XG + (size_t)row * 256 + col) = o;
    }, 64);
    PH(2) for (;;) {
      LAUNDER_TID();
      if (tid == 0) xb_st[2] = xb_add(&BAR[XB_WQ(l * 2 + 0)], 1u);
      __syncthreads();
      const int item0 = (int)xb_st[2];
      __syncthreads();
      if (item0 >= 800 * (((REP_MASK >> 2) & 1) + 1)) break;
      int item = item0 % 800;
      int kind, sub;
      if (item < 32) { kind = 0; sub = 128 + item; }
      else if (item < 288) { kind = 1; sub = item - 32; }
      else if (item < 416) { kind = 0; sub = item - 288; }
      else if (item < 672) { kind = 2; sub = item - 416; }
      else { kind = 3; sub = item - 672; }
      if (kind == 0) {
        int s = sub >> 2, gq = sub & 3;
        int g = gq * 4 + (wave >> 1), dir = wave & 1;
        int L = s < 32 ? 256 : 1024;
        int row0 = s < 32 ? s * 256 : 8192 + (s - 32) * 1024;
        float* BUs = (float*)(smem_raw + wave * S5_WAVE_BYTES);
        bf16_t* Hs = (bf16_t*)(smem_raw + wave * S5_WAVE_BYTES + 8448);
        float lbr, lbi;
        {
          float cr, ci;
          s5_disc(p, l, dir, g, lane, lbr, lbi, cr, ci);
        }
        bf16x8 bfrag[8];
#pragma unroll
        for (int nb = 0; nb < 4; ++nb) {
          int n2 = nb * 16 + l15;
          float t0, t1, cr, ci;
          s5_disc(p, l, dir, g, n2, t0, t1, cr, ci);
          union { uint4 u; bf16x8 v; } fr_, fi_;
          fr_.u = make_uint4(0, 0, 0, 0); fi_.u = make_uint4(0, 0, 0, 0);
          if (quad < 2) {
            const float* br = p.s5_b_re + ((size_t)(l * 16 + g) * 64 + n2) * 16 + quad * 8;
            const float* bi = p.s5_b_im + ((size_t)(l * 16 + g) * 64 + n2) * 16 + quad * 8;
            float4 r0 = *(const float4*)br, r1 = *(const float4*)(br + 4);
            float4 i0 = *(const float4*)bi, i1 = *(const float4*)(bi + 4);
            fr_.u.x = pack2(cr * r0.x - ci * i0.x, cr * r0.y - ci * i0.y);
            fr_.u.y = pack2(cr * r0.z - ci * i0.z, cr * r0.w - ci * i0.w);
            fr_.u.z = pack2(cr * r1.x - ci * i1.x, cr * r1.y - ci * i1.y);
            fr_.u.w = pack2(cr * r1.z - ci * i1.z, cr * r1.w - ci * i1.w);
            fi_.u.x = pack2(cr * i0.x + ci * r0.x, cr * i0.y + ci * r0.y);
            fi_.u.y = pack2(cr * i0.z + ci * r0.z, cr * i0.w + ci * r0.w);
            fi_.u.z = pack2(cr * i1.x + ci * r1.x, cr * i1.y + ci * r1.y);
            fi_.u.w = pack2(cr * i1.z + ci * r1.z, cr * i1.w + ci * r1.w);
          }
          bfrag[nb] = fr_.v; bfrag[4 + nb] = fi_.v;
        }
        bf16x8 cfrag[4];
#pragma unroll
        for (int ks = 0; ks < 4; ++ks) {
          const float* cp = (ks < 2 ? p.s5_c_re : p.s5_c_im) + (size_t)((l * 2 + dir) * 16 + g) * 1024 + l15 * 64 + (ks & 1) * 32 + quad * 8;
          float sg = ks < 2 ? 1.f : -1.f;
          float4 c0 = *(const float4*)cp, c1 = *(const float4*)(cp + 4);
          union { uint4 u; bf16x8 v; } cf;
          cf.u.x = pack2(sg * c0.x, sg * c0.y); cf.u.y = pack2(sg * c0.z, sg * c0.w);
          cf.u.z = pack2(sg * c1.x, sg * c1.y); cf.u.w = pack2(sg * c1.z, sg * c1.w);
          cfrag[ks] = cf.v;
        }
        float hr = 0.f, hi = 0.f;
        if (s >= 32) {
          int si = ((((s - 32) * 2 + l) * 2 + dir) * 16 + g) * 64 + lane;
          hr = p.st_s5_re[si]; hi = p.st_s5_im[si];
        }
        bf16_t* ydst = dir == 0 ? S5Y : MG;
        __syncthreads();
        auto load_u = [&](int kb) -> uint4 {
          uint4 r = make_uint4(0, 0, 0, 0);
          int k = kb * 16 + l15;
          int t = dir ? (L - 1 - k) : k;
          if (quad < 2) r = *(const uint4*)(U + (size_t)(row0 + t) * 256 + g * 16 + quad * 8);
          return r;
        };
        uint4 ucur = load_u(0);
        const int nkb = L / 16;
        for (int kb = 0; kb < nkb; ++kb) {
          uint4 unext = make_uint4(0, 0, 0, 0);
          if (kb + 1 < nkb) unext = load_u(kb + 1);
          union { uint4 u; bf16x8 v; } uf;
          uf.u = ucur;
#pragma unroll
          for (int cb = 0; cb < 8; ++cb) {
            f32x4 a = {0.f, 0.f, 0.f, 0.f};
            a = __builtin_amdgcn_mfma_f32_16x16x32_bf16(uf.v, bfrag[cb], a, 0, 0, 0);
#pragma unroll
            for (int e = 0; e < 4; ++e) BUs[(quad * 4 + e) * S5_BUS + cb * 16 + l15] = a[e];
          }
          __builtin_amdgcn_wave_barrier();
#pragma unroll
          for (int i = 0; i < 16; ++i) {
            float bur = BUs[i * S5_BUS + lane], bui = BUs[i * S5_BUS + 64 + lane];
            float nr = lbr * hr - lbi * hi + bur;
            float ni = lbr * hi + lbi * hr + bui;
            hr = nr; hi = ni;
            Hs[i * S5_HS + lane] = f2bf(hr);
            Hs[i * S5_HS + 64 + lane] = f2bf(hi);
          }
          __builtin_amdgcn_wave_barrier();
          {
            f32x4 y = {0.f, 0.f, 0.f, 0.f};
#pragma unroll
            for (int ks = 0; ks < 4; ++ks) {
              bf16x8 hf = *(const bf16x8*)(Hs + l15 * S5_HS + ks * 32 + quad * 8);
              y = __builtin_amdgcn_mfma_f32_16x16x32_bf16(hf, cfrag[ks], y, 0, 0, 0);
            }
#pragma unroll
            for (int e = 0; e < 4; ++e) {
              int k = kb * 16 + quad * 4 + e;
              int t = dir ? (L - 1 - k) : k;
              ydst[(size_t)(row0 + t) * 256 + g * 16 + l15] = f2bf(y[e]);
            }
          }
          __builtin_amdgcn_wave_barrier();
          ucur = unext;
        }
        if (s < 32) {
          int oi = (((s * 2 + l) * 2 + dir) * 16 + g) * 64 + lane;
          p.out[OUT_S5RE + oi] = hr;
          p.out[OUT_S5IM + oi] = hi;
        }
        __syncthreads();
        {
          const float* dptr = p.s5_d + l * 256 + gq * 64;
#pragma unroll 4
          for (int idx = tid; idx < L * 8; idx += 512) {
            int t = idx >> 3, c8 = (idx & 7) * 8;
            size_t off = (size_t)(row0 + t) * 256 + gq * 64 + c8;
            uint4 yf = *(const uint4*)(S5Y + off), yb = *(const uint4*)(MG + off), uu = *(const uint4*)(U + off);
            float4 d0 = *(const float4*)(dptr + c8), d1 = *(const float4*)(dptr + c8 + 4);
            uint4 o;
            o.x = pack2(gelu_(lo2f(yf.x) + lo2f(yb.x) + d0.x * lo2f(uu.x)), gelu_(hi2f(yf.x) + hi2f(yb.x) + d0.y * hi2f(uu.x)));
            o.y = pack2(gelu_(lo2f(yf.y) + lo2f(yb.y) + d0.z * lo2f(uu.y)), gelu_(hi2f(yf.y) + hi2f(yb.y) + d0.w * hi2f(uu.y)));
            o.z = pack2(gelu_(lo2f(yf.z) + lo2f(yb.z) + d1.x * lo2f(uu.z)), gelu_(hi2f(yf.z) + hi2f(yb.z) + d1.y * hi2f(uu.z)));
            o.w = pack2(gelu_(lo2f(yf.w) + lo2f(yb.w) + d1.z * lo2f(uu.w)), gelu_(hi2f(yf.w) + hi2f(yb.w) + d1.w * hi2f(uu.w)));
            *(uint4*)(S5Y + off) = o;
          }
        }
        __syncthreads();
      } else if (kind == 1 || kind == 2) {
        bf16_t* KS = (bf16_t*)smem_raw;
        bf16_t* VS = (bf16_t*)(smem_raw + 65536);
        int b, h, nkeys, vss, kgld, rp = 0;
        const bf16_t *kg, *vg;
        if (kind == 2) { h = sub & 7; b = sub >> 3; nkeys = 256; vss = 264; kg = KB + (size_t)(b * 256) * 512 + h * 64; kgld = 512; vg = VTC + (size_t)((b * 8 + h) * 64) * 256; }
        else { rp = sub & 3; h = (sub >> 2) & 7; b = sub >> 5; nkeys = 512; vss = 520; kg = KC + (size_t)((b * 8 + h) * 512) * 64; kgld = 64; vg = VCT + (size_t)((b * 8 + h) * 64) * 512; }
        for (int idx = tid; idx < nkeys * 8; idx += 512) {
          int key = idx >> 3, ch = idx & 7;
          uint4 v = *(const uint4*)(kg + (size_t)key * kgld + ch * 8);
          *(uint4*)(KS + key * 64 + ((ch ^ (key & 7)) * 8)) = v;
        }
        {
          const int cpr = nkeys >> 3, sh = (kind == 2) ? 5 : 6;
          for (int idx = tid; idx < 64 * cpr; idx += 512) {
            int d = idx >> sh, ch = idx & (cpr - 1);
            uint4 v = *(const uint4*)(vg + (size_t)d * nkeys + ch * 8);
            *(uint4*)(VS + d * vss + ch * 8) = v;
          }
        }
        __syncthreads();
        {
          AttnState st0, st1;
#pragma unroll
          for (int db = 0; db < 4; ++db) { st0.o[db] = f32x4{0.f, 0.f, 0.f, 0.f}; st1.o[db] = f32x4{0.f, 0.f, 0.f, 0.f}; }
          st0.m = -1e30f; st0.lsum = 0.f; st1.m = -1e30f; st1.lsum = 0.f;
          bf16x8 qf0[2], qf1[2];
          bf16_t *orow0, *orow1;
          int r0 = 0, r1 = 0, j = 0, band0 = 0, qcol = 0, win0 = 0, nloc = 0;
          const float* rp_ = p.rpb;
          int tok0 = 0;
          if (kind == 2) {
            orow0 = QB + (size_t)(b * 256 + wave * 16 + l15) * 512 + h * 64;
            orow1 = orow0 + (size_t)128 * 512;
          } else {
            r0 = rp * 4 + (wave >> 2) * 2; r1 = r0 + 1;
            j = wave & 3;
            tok0 = 8192 + b * 1024;
            orow0 = QB + (size_t)(tok0 + r0 * 64 + j * 16 + l15) * 512 + h * 64;
            orow1 = orow0 + (size_t)64 * 512;
            band0 = min(max(j * 16 - 8, 0), 32);
            qcol = j * 16 + l15;
            win0 = min(max(qcol - 8, 0), 48);
            rp_ = p.rpb + (size_t)(l * 8 + h) * 15 * 31;
            nloc = 8;
          }
          qf0[0] = *(const bf16x8*)(orow0 + quad * 8); qf0[1] = *(const bf16x8*)(orow0 + 32 + quad * 8);
          qf1[0] = *(const bf16x8*)(orow1 + quad * 8); qf1[1] = *(const bf16x8*)(orow1 + 32 + quad * 8);
          auto softmax_pv = [&](AttnState& st, float (&sc_)[8], const bf16x8 (&va)[4]) {
            float tm = sc_[0];
#pragma unroll
            for (int i = 1; i < 8; ++i) tm = fmaxf(tm, sc_[i]);
            tm = quad_max(tm);
            if (__builtin_amdgcn_ballot_w64(tm > st.m + 8.f)) {
              float mn = fmaxf(st.m, tm);
              float alpha = __builtin_amdgcn_exp2f(st.m - mn);
              st.m = mn;
              st.lsum *= alpha;
#pragma unroll
              for (int db = 0; db < 4; ++db) { st.o[db][0] *= alpha; st.o[db][1] *= alpha; st.o[db][2] *= alpha; st.o[db][3] *= alpha; }
            }
            float pv[8];
            float ps = 0.f;
#pragma unroll
            for (int i = 0; i < 8; ++i) { pv[i] = __builtin_amdgcn_exp2f(sc_[i] - st.m); ps += pv[i]; }
            st.lsum += ps;
            union { uint4 u; bf16x8 v; } pb;
            pb.u.x = pack2(pv[0], pv[1]); pb.u.y = pack2(pv[2], pv[3]); pb.u.z = pack2(pv[4], pv[5]); pb.u.w = pack2(pv[6], pv[7]);
#pragma unroll
            for (int db = 0; db < 4; ++db) st.o[db] = __builtin_amdgcn_mfma_f32_16x16x32_bf16(va[db], pb.v, st.o[db], 0, 0, 0);
          };
          const int nct = nkeys >> 5;
          for (int t = 0; t < nct; ++t) {
            bf16x8 kf[4];
#pragma unroll
            for (int half = 0; half < 2; ++half) {
              int key = t * 32 + half * 16 + l15;
              const bf16_t* kr = KS + key * 64;
              kf[half * 2] = *(const bf16x8*)(kr + ((quad ^ (key & 7)) * 8));
              kf[half * 2 + 1] = *(const bf16x8*)(kr + (((quad + 4) ^ (key & 7)) * 8));
            }
            bf16x8 va[4];
#pragma unroll
            for (int db = 0; db < 4; ++db) {
              const bf16_t* vp = VS + (db * 16 + l15) * vss + t * 32 + quad * 4;
              uint2 lo = *(const uint2*)vp, hi = *(const uint2*)(vp + 16);
              union { uint4 u; bf16x8 v; } x; x.u.x = lo.x; x.u.y = lo.y; x.u.z = hi.x; x.u.w = hi.y;
              va[db] = x.v;
            }
            float sa[8], sb[8];
#pragma unroll
            for (int half = 0; half < 2; ++half) {
              f32x4 a0 = {0.f, 0.f, 0.f, 0.f}, a1 = {0.f, 0.f, 0.f, 0.f};
              a0 = __builtin_amdgcn_mfma_f32_16x16x32_bf16(kf[half * 2], qf0[0], a0, 0, 0, 0);
              a1 = __builtin_amdgcn_mfma_f32_16x16x32_bf16(kf[half * 2], qf1[0], a1, 0, 0, 0);
              a0 = __builtin_amdgcn_mfma_f32_16x16x32_bf16(kf[half * 2 + 1], qf0[1], a0, 0, 0, 0);
              a1 = __builtin_amdgcn_mfma_f32_16x16x32_bf16(kf[half * 2 + 1], qf1[1], a1, 0, 0, 0);
#pragma unroll
              for (int e = 0; e < 4; ++e) { sa[half * 4 + e] = a0[e]; sb[half * 4 + e] = a1[e]; }
            }
            softmax_pv(st0, sa, va);
            softmax_pv(st1, sb, va);
          }
          if (nloc) {
            const int rb0 = min(max(r0 - 4, 0), 8), rb1 = min(max(r1 - 4, 0), 8);
            const int nu = rb1 + 8 - rb0;
            const bf16_t* k2 = KB + (size_t)(tok0 + rb0 * 64 + band0) * 512 + h * 64;
            const bf16_t* v2 = VTL + (size_t)((b * 8 + h) * 64) * 1024 + rb0 * 64 + band0;
            auto load_k = [&](int u, bf16x8 (&kk)[4]) {
              const bf16_t* kb_ = k2 + (size_t)(u * 64) * 512;
#pragma unroll
              for (int half = 0; half < 2; ++half) {
                const bf16_t* kp = kb_ + (size_t)(half * 16 + l15) * 512 + quad * 8;
                kk[half * 2] = *(const bf16x8*)kp;
                kk[half * 2 + 1] = *(const bf16x8*)(kp + 32);
              }
            };
            auto one_tile = [&](AttnState& st, const bf16x8 (&qf)[2], int r, int rr, const bf16x8 (&kk)[4], const bf16x8 (&va)[4]) {
              float sc_[8];
#pragma unroll
              for (int half = 0; half < 2; ++half) {
                f32x4 acc = {0.f, 0.f, 0.f, 0.f};
                acc = __builtin_amdgcn_mfma_f32_16x16x32_bf16(kk[half * 2], qf[0], acc, 0, 0, 0);
                acc = __builtin_amdgcn_mfma_f32_16x16x32_bf16(kk[half * 2 + 1], qf[1], acc, 0, 0, 0);
#pragma unroll
                for (int e = 0; e < 4; ++e) sc_[half * 4 + e] = acc[e];
              }
              int dy = rr - r + 7;
#pragma unroll
              for (int i = 0; i < 8; ++i) {
                int kc = band0 + (i >> 2) * 16 + quad * 4 + (i & 3);
                bool valid = (kc >= win0) && (kc < win0 + 16);
                int dx = min(max(kc - qcol + 15, 0), 30);
                float bias = rp_[dy * 31 + dx] * 1.4426950408889634f;
                sc_[i] = valid ? sc_[i] + bias : -1e30f;
              }
              softmax_pv(st, sc_, va);
            };
            auto do_row = [&](int u, const bf16x8 (&kk)[4]) {
              bf16x8 va[4];
              {
                const bf16_t* vt_ = v2 + u * 64;
#pragma unroll
                for (int db = 0; db < 4; ++db) {
                  const bf16_t* vp = vt_ + (size_t)(db * 16 + l15) * 1024 + quad * 4;
                  uint2 lo = *(const uint2*)vp, hi = *(const uint2*)(vp + 16);
                  union { uint4 u4; bf16x8 v; } x; x.u4.x = lo.x; x.u4.y = lo.y; x.u4.z = hi.x; x.u4.w = hi.y;
                  va[db] = x.v;
                }
              }
              const int rr = rb0 + u;
              if (u < 8) one_tile(st0, qf0, r0, rr, kk, va);
              if (rr >= rb1) one_tile(st1, qf1, r1, rr, kk, va);
            };
#pragma unroll 1
            for (int u = 0; u < nu; ++u) {
              bf16x8 kk[4];
              load_k(u, kk);
              do_row(u, kk);
            }
          }
          {
            float inv0 = __builtin_amdgcn_rcpf(quad_sum(st0.lsum)), inv1 = __builtin_amdgcn_rcpf(quad_sum(st1.lsum));
#pragma unroll
            for (int db = 0; db < 4; ++db) {
              uint2 pk;
              pk.x = pack2(st0.o[db][0] * inv0, st0.o[db][1] * inv0);
              pk.y = pack2(st0.o[db][2] * inv0, st0.o[db][3] * inv0);
              *(uint2*)(orow0 + db * 16 + quad * 4) = pk;
              pk.x = pack2(st1.o[db][0] * inv1, st1.o[db][1] * inv1);
              pk.y = pack2(st1.o[db][2] * inv1, st1.o[db][3] * inv1);
              *(uint2*)(orow1 + db * 16 + quad * 4) = pk;
            }
          }
        }
      } else {
        int ch = tid & 255;
        int r0 = sub * 128 + (tid >> 8) * 64;
        int L = r0 < 8192 ? 256 : 1024;
        float w0 = p.lru_conv_w[l * 1024 + ch], w1 = p.lru_conv_w[l * 1024 + 256 + ch];
        float w2 = p.lru_conv_w[l * 1024 + 512 + ch], w3 = p.lru_conv_w[l * 1024 + 768 + ch];
        float cb = p.lru_conv_b[l * 256 + ch];
#pragma unroll 1
        for (int c0 = 0; c0 < 64; c0 += 16) {
          int rc = r0 + c0;
          int tc = rc & (L - 1);
          const bf16_t* xp = XR + (size_t)rc * 256 + ch;
          float xv[19];
#pragma unroll
          for (int i = 0; i < 19; ++i) {
            int tt = tc + i - 2;
            xv[i] = (tt >= 0 && tt < L) ? bf2f(xp[(i - 2) * 256]) : 0.f;
          }
#pragma unroll
          for (int i = 0; i < 16; ++i)
            LRUY[(size_t)(rc + i) * 256 + ch] = f2bf(cb + w0 * xv[i] + w1 * xv[i + 1] + w2 * xv[i + 2] + w3 * xv[i + 3]);
        }
      }
    }
    GSYNC();

    const float* const lba = p.lru_b_a + l * 512;
    const float* const lbx = p.lru_b_x + l * 512;
    PH(3) run_gemm(lds, LRUY, 256, WT + WT_LRU, 256, 1024, 256, [=](int row, int col, f32x4 v) {
      int dir = col >> 9, gate = (col >> 8) & 1, ch = col & 255;
      f32x4 bias = *(const f32x4*)((gate ? lbx : lba) + dir * 256 + ch);
      float s0 = sigmoidf_(v[0] + bias[0]), s1 = sigmoidf_(v[1] + bias[1]), s2 = sigmoidf_(v[2] + bias[2]), s3 = sigmoidf_(v[3] + bias[3]);
      if (gate) {
        uint2 xc = *(const uint2*)(LRUY + (size_t)row * 256 + ch);
        s0 *= lo2f(xc.x); s1 *= hi2f(xc.x); s2 *= lo2f(xc.y); s3 *= hi2f(xc.y);
      }
      uint2 o; o.x = pack2(s0, s1); o.y = pack2(s2, s3);
      *(uint2*)(MG + (size_t)row * 1024 + col) = o;
    });
    __builtin_amdgcn_sched_barrier(0);
    __builtin_amdgcn_sched_barrier(0);
    PH(10) run_gemm(lds, S5Y, 256, WT + WT_GLU, 256, 256, 256, [=](int row, int col, f32x4 v) {
      uint2 yy = *(const uint2*)(S5Y + (size_t)row * 256 + col);
      uint2 o;
      o.x = pack2(lo2f(yy.x) * sigmoidf_(v[0]), hi2f(yy.x) * sigmoidf_(v[1]));
      o.y = pack2(lo2f(yy.y) * sigmoidf_(v[2]), hi2f(yy.y) * sigmoidf_(v[3]));
      *(uint2*)(U + (size_t)row * 256 + col) = o;
    });
    GSYNC();

    PH(4) for (;;) {
      LAUNDER_TID();
      if (tid == 0) xb_st[2] = xb_add(&BAR[XB_WQ(l * 2 + 1)], 1u);
      __syncthreads();
      const int qi = (int)xb_st[2];
      __syncthreads();
      if (qi >= 320) break;
      const int item = qi < 64 ? 256 + qi : qi - 64;
      const int s = item >> 3, ch0 = (item & 7) * 32;
      const int L = s < 32 ? 256 : 1024;
      const int Lq = L >> 3;
      const int row0 = s < 32 ? s * 256 : 8192 + (s - 32) * 1024;
      const int dir = lane >> 5, q = wave;
      const int ch = ch0 + (lane & 31);
      float* E_ = (float*)smem_raw;
      float* PT = E_ + 512;
      float* CAR = PT + 512;
      float lam = p.lru_lam[l * 512 + dir * 256 + ch];
      float sp = log1pf(expf(-lam));
      float h = 0.f, P = 1.f;
      bf16_t* base = MG + dir * 512 + ch;
      {
        const int kbeg = q * Lq, kend = (q + 1) * Lq;
        uint32_t cur[8], nxt[8];
        auto ld8 = [&](int kb, uint32_t (&d)[8]) {
#pragma unroll
          for (int i = 0; i < 8; ++i) {
            int k = kb + i;
            int t = dir ? (L - 1 - k) : k;
            const bf16_t* qq = base + (size_t)(row0 + t) * 1024;
            d[i] = (uint32_t)qq[0] | ((uint32_t)qq[256] << 16);
          }
        };
        ld8(kbeg, cur);
        for (int kb = kbeg; kb < kend; kb += 8) {
          if (kb + 8 < kend) ld8(kb + 8, nxt);
          float hv[8], pv_[8];
#pragma unroll
          for (int i = 0; i < 8; ++i) {
            float rvv = lo2f(cur[i]), xvv = hi2f(cur[i]);
            float la = -8.f * rvv * sp;
            float a = __expf(la);
            float x2 = 2.f * la;
            float ser = -x2 * (1.f + x2 * (0.5f + x2 * (0.16666667f + x2 * (0.041666668f + x2 * (0.0083333338f + x2 * 0.0013888889f)))));
            float om = x2 > -0.25f ? ser : 1.f - a * a;
            float bm = __builtin_amdgcn_sqrtf(fmaxf(om, 0.f)) * xvv;
            h = a * h + bm;
            P = a * P;
            hv[i] = h; pv_[i] = P;
          }
#pragma unroll
          for (int i = 0; i < 8; ++i) {
            int k = kb + i;
            int t = dir ? (L - 1 - k) : k;
            bf16_t* qq = base + (size_t)(row0 + t) * 1024;
            uint32_t pk = pack2(hv[i], pv_[i]);
            qq[0] = (bf16_t)(pk & 0xffffu);
            qq[256] = (bf16_t)(pk >> 16);
          }
#pragma unroll
          for (int i = 0; i < 8; ++i) cur[i] = nxt[i];
        }
      }
      E_[wave * 64 + lane] = h;
      PT[wave * 64 + lane] = P;
      __syncthreads();
      {
        float c = 0.f;
        if (s >= 32) c = p.st_lru[(((s - 32) * 2 + l) * 2 + dir) * 256 + ch];
        for (int q2 = 0; q2 < q; ++q2) c = PT[q2 * 64 + lane] * c + E_[q2 * 64 + lane];
        CAR[wave * 64 + lane] = c;
        if (q == 7 && s < 32) p.out[OUT_LRU + ((s * 2 + l) * 2 + dir) * 256 + ch] = P * c + h;
      }
      __syncthreads();
      {
#pragma unroll 2
        for (int idx = tid; idx < L * 4; idx += 512) {
          int t = idx >> 2, c8 = (idx & 3) * 8;
          int qf_ = t / Lq, qb_ = (L - 1 - t) / Lq;
          size_t row = row0 + t;
          const bf16_t* mp = MG + row * 1024 + ch0 + c8;
          uint4 h0 = *(const uint4*)mp, p0 = *(const uint4*)(mp + 256), h1 = *(const uint4*)(mp + 512), p1 = *(const uint4*)(mp + 768);
          uint4 gg = *(const uint4*)(XG + row * 256 + ch0 + c8);
          const float* cf = CAR + qf_ * 64 + c8;
          const float* cbk = CAR + qb_ * 64 + 32 + c8;
          float4 cf0 = *(const float4*)cf, cf1 = *(const float4*)(cf + 4), cb0 = *(const float4*)cbk, cb1 = *(const float4*)(cbk + 4);
          uint4 o;
          o.x = pack2((lo2f(h0.x) + lo2f(p0.x) * cf0.x + lo2f(h1.x) + lo2f(p1.x) * cb0.x) * gelu_(lo2f(gg.x)),
                      (hi2f(h0.x) + hi2f(p0.x) * cf0.y + hi2f(h1.x) + hi2f(p1.x) * cb0.y) * gelu_(hi2f(gg.x)));
          o.y = pack2((lo2f(h0.y) + lo2f(p0.y) * cf0.z + lo2f(h1.y) + lo2f(p1.y) * cb0.z) * gelu_(lo2f(gg.y)),
                      (hi2f(h0.y) + hi2f(p0.y) * cf0.w + hi2f(h1.y) + hi2f(p1.y) * cb0.w) * gelu_(hi2f(gg.y)));
          o.z = pack2((lo2f(h0.z) + lo2f(p0.z) * cf1.x + lo2f(h1.z) + lo2f(p1.z) * cb1.x) * gelu_(lo2f(gg.z)),
                      (hi2f(h0.z) + hi2f(p0.z) * cf1.y + hi2f(h1.z) + hi2f(p1.z) * cb1.y) * gelu_(hi2f(gg.z)));
          o.w = pack2((lo2f(h0.w) + lo2f(p0.w) * cf1.z + lo2f(h1.w) + lo2f(p1.w) * cb1.z) * gelu_(lo2f(gg.w)),
                      (hi2f(h0.w) + hi2f(p0.w) * cf1.w + hi2f(h1.w) + hi2f(p1.w) * cb1.w) * gelu_(hi2f(gg.w)));
          *(uint4*)(LRUY + row * 256 + ch0 + c8) = o;
        }
      }
      __syncthreads();
    }
    GSYNC();

    PH(5) {
      pg8::StaticOrder S; S.init(16384, 1024, gridDim.x, blockIdx.x);
      int k0 = 512, k12 = 256;
      asm volatile("" : "+s"(k0), "+s"(k12));
      const unsigned char* const Gp = G8;
      bf16_t* const MGp = MG;
      pg8::gemm_phase_seg(lds, QB, U, LRUY, WT + WT_BRA, WT + WT_BRS, WT + WT_BRL, k0, k12, S,
        pg8::make_epi_seg(
          [=](int row, int col, int seg) -> uint2 {
            const unsigned char* gp = Gp + (size_t)row * 3072 + col;
            uint2 r;
            r.x = *(const uint32_t*)(gp + seg * 1024);
            r.y = *(const uint32_t*)(gp + (seg < 2 ? seg + 1 : 2) * 1024);
            return r;
          },
          [=](int row, int col, f32x4& v, int seg, uint2 g) {
          const uint32_t ga = g.x, gb = g.y;
          float a0 = (float)max((int)(ga & 255u), 1), a1 = (float)max((int)((ga >> 8) & 255u), 1);
          float a2 = (float)max((int)((ga >> 16) & 255u), 1), a3 = (float)max((int)(ga >> 24), 1);
          if (seg < 2) {
            float b0 = (float)max((int)(gb & 255u), 1), b1 = (float)max((int)((gb >> 8) & 255u), 1);
            float b2 = (float)max((int)((gb >> 16) & 255u), 1), b3 = (float)max((int)(gb >> 24), 1);
            v[0] = v[0] * (a0 * __builtin_amdgcn_rcpf(b0)); v[1] = v[1] * (a1 * __builtin_amdgcn_rcpf(b1)); v[2] = v[2] * (a2 * __builtin_amdgcn_rcpf(b2)); v[3] = v[3] * (a3 * __builtin_amdgcn_rcpf(b3));
          } else {
            const float sc_ = 1.f / 255.f;
            uint2 o; o.x = pack2(v[0] * (a0 * sc_), v[1] * (a1 * sc_)); o.y = pack2(v[2] * (a2 * sc_), v[3] * (a3 * sc_));
            *(uint2*)(MGp + (size_t)row * 1024 + col) = o;
          }
        }));
    }
    GSYNC();

    const float* const xin0 = p.x_prompt;
    const float* const xin1 = p.x_sample;
    PH(6) run_gemm(lds, MG, 1024, WT + WT_OUT, 1024, 1024, 1024, [=](int row, int col, f32x4 v) {
      f32x4 gt = *(const f32x4*)(MOD + (size_t)modrow(row) * 6144 + 2048 + col);
      const float* xs = l == 0 ? (row < 8192 ? xin0 + (size_t)row * 1024 : xin1 + (size_t)(row - 8192) * 1024) : X + (size_t)row * 1024;
      f32x4 xv = *(const f32x4*)(xs + col);
      *(f32x4*)(X + (size_t)row * 1024 + col) = xv + gt * v;
    });
    GSYNC();

    PH(13) norm_phase(p, l, 1, false, tid);
    GSYNC();

    bf16_t* const FAB = (bf16_t*)UB;
    PH(7) run_gemm(lds, HBUF, 1024, WT + WT_UP, 1024, 5632, 1024, [=](int row, int col, f32x4 v) {
      uint2 o; o.x = pack2(v[0], v[1]); o.y = pack2(v[2], v[3]);
      *(uint2*)(FAB + (size_t)row * 5632 + col) = o;
    });
    GSYNC();

    {
      LAUNDER_TID();
      const float* const fcw = p.ffn_conv_w + l * 3 * 2816;
      const float* const fcb = p.ffn_conv_b + l * 2816;
      for (int it = blockIdx.x * 512 + tid; it < 1024 * 352; it += gridDim.x * 512) {
        int rb = it / 352, cc = it - rb * 352;
        int r0 = rb * 16, col = cc * 8;
        int L = r0 < 8192 ? 256 : 1024;
        int t0 = r0 & (L - 1);
        const float* cw = fcw + col;
        float4 w0a = *(const float4*)cw, w0b = *(const float4*)(cw + 4);
        float4 w1a = *(const float4*)(cw + 2816), w1b = *(const float4*)(cw + 2820);
        float4 w2a = *(const float4*)(cw + 5632), w2b = *(const float4*)(cw + 5636);
        float4 cba = *(const float4*)(fcb + col), cbb = *(const float4*)(fcb + col + 4);
        const bf16_t* ap = FAB + (size_t)r0 * 5632 + col;
        bf16_t* bp = FAB + (size_t)r0 * 5632 + 2816 + col;
        uint4 am1 = make_uint4(0, 0, 0, 0);
        if (t0 > 0) am1 = *(const uint4*)(ap - 5632);
        uint4 a0 = *(const uint4*)ap;
        const bool tail_ok = (t0 + 16 < L);
#pragma unroll 1
        for (int i0 = 0; i0 < 16; i0 += 4) {
          uint4 an[4], bb[4];
#pragma unroll
          for (int jj = 0; jj < 4; ++jj) {
            int i = i0 + jj;
            an[jj] = make_uint4(0, 0, 0, 0);
            if (i < 15 || tail_ok) an[jj] = *(const uint4*)(ap + (size_t)(i + 1) * 5632);
            bb[jj] = *(const uint4*)(bp + (size_t)i * 5632);
          }
#pragma unroll
          for (int jj = 0; jj < 4; ++jj) {
            uint4 o;
            {
              float x0 = cba.x + w0a.x * lo2f(am1.x) + w1a.x * lo2f(a0.x) + w2a.x * lo2f(an[jj].x);
              float x1 = cba.y + w0a.y * hi2f(am1.x) + w1a.y * hi2f(a0.x) + w2a.y * hi2f(an[jj].x);
              o.x = pack2(gelu_(x0) * lo2f(bb[jj].x), gelu_(x1) * hi2f(bb[jj].x));
              float x2 = cba.z + w0a.z * lo2f(am1.y) + w1a.z * lo2f(a0.y) + w2a.z * lo2f(an[jj].y);
              float x3 = cba.w + w0a.w * hi2f(am1.y) + w1a.w * hi2f(a0.y) + w2a.w * hi2f(an[jj].y);
              o.y = pack2(gelu_(x2) * lo2f(bb[jj].y), gelu_(x3) * hi2f(bb[jj].y));
              float x4 = cbb.x + w0b.x * lo2f(am1.z) + w1b.x * lo2f(a0.z) + w2b.x * lo2f(an[jj].z);
              float x5 = cbb.y + w0b.y * hi2f(am1.z) + w1b.y * hi2f(a0.z) + w2b.y * hi2f(an[jj].z);
              o.z = pack2(gelu_(x4) * lo2f(bb[jj].z), gelu_(x5) * hi2f(bb[jj].z));
              float x6 = cbb.z + w0b.z * lo2f(am1.w) + w1b.z * lo2f(a0.w) + w2b.z * lo2f(an[jj].w);
              float x7 = cbb.w + w0b.w * hi2f(am1.w) + w1b.w * hi2f(a0.w) + w2b.w * hi2f(an[jj].w);
              o.w = pack2(gelu_(x6) * lo2f(bb[jj].w), gelu_(x7) * hi2f(bb[jj].w));
            }
            *(uint4*)(bp + (size_t)(i0 + jj) * 5632) = o;
            am1 = a0; a0 = an[jj];
          }
        }
      }
    }
    GSYNC();

    PH(9) run_gemm(lds, FAB + 2816, 5632, WT + WT_DOWN, 2816, 1024, 2816, [=](int row, int col, f32x4 v) {
      f32x4 gt = *(const f32x4*)(MOD + (size_t)modrow(row) * 6144 + 5120 + col);
      f32x4* xp = (f32x4*)(X + (size_t)row * 1024 + col);
      *xp = *xp + gt * v;
    });
    GSYNC();
  }

  {
  LAUNDER_TID();
  for (int r = blockIdx.x * 8 + wave; r < 16384; r += gridDim.x * 8) {
    float* xr = X + (size_t)r * 1024;
    float4 v[4];
    float ss = 0.f;
#pragma unroll
    for (int i = 0; i < 4; ++i) {
      v[i] = *(const float4*)(xr + i * 256 + lane * 4);
      ss += v[i].x * v[i].x + v[i].y * v[i].y + v[i].z * v[i].z + v[i].w * v[i].w;
    }
#pragma unroll
    for (int o = 32; o >= 1; o >>= 1) ss += __shfl_xor(ss, o);
    float rstd = rsqrtf(ss * (1.f / 1024.f) + 1e-6f);
#pragma unroll
    for (int i = 0; i < 4; ++i) {
      int c = i * 256 + lane * 4;
      float4 gg = *(const float4*)(p.g_final + c);
      float4 o;
      o.x = v[i].x * rstd * gg.x; o.y = v[i].y * rstd * gg.y; o.z = v[i].z * rstd * gg.z; o.w = v[i].w * rstd * gg.w;
      *(float4*)(xr + c) = o;
    }
  }
  }
}

extern "C" void kernel_launch(void* const* d_in, const int* in_sizes, int n_in, void* d_out, int out_size, void* d_ws,
                              size_t ws_size, hipStream_t stream) {
  static int grid_blocks = 0;
  if (!grid_blocks) {
    int dev = 0, cus = 0;
    (void)hipGetDevice(&dev);
    (void)hipDeviceGetAttribute(&cus, hipDeviceAttributeMultiprocessorCount, dev);
    (void)hipFuncSetAttribute((const void*)mega, hipFuncAttributeMaxDynamicSharedMemorySize, LDS_BYTES);
    int per_cu = 0;
    (void)hipOccupancyMaxActiveBlocksPerMultiprocessor(&per_cu, (const void*)mega, 512, LDS_BYTES);
    (void)hipGetLastError();
    grid_blocks = cus > 0 ? cus : 256;
  }
  Params p{};
  const float** pp = (const float**)&p;
  for (int i = 0; i < 40; ++i) pp[i] = (const float*)d_in[i];
  p.out = (float*)d_out;
  p.ws = (char*)d_ws;
  (void)hipMemsetAsync((char*)d_ws + WS_BAR, 0, XCD_BAR_WORDS * 4, stream);
  void* args[] = {&p};
  hipError_t e = hipLaunchCooperativeKernel((const void*)mega, dim3(grid_blocks), dim3(512), args, LDS_BYTES, stream);
  if (e != hipSuccess) fprintf(stderr, "cooperative launch failed: %s (grid %d)\n", hipGetErrorString(e), grid_blocks);
}
```

```cpp
#include <hip/hip_runtime.h>
#include <hip/hip_cooperative_groups.h>
#include <stdint.h>
#include <cstdio>
namespace cg = cooperative_groups;

#define LAS __attribute__((address_space(3)))
typedef unsigned short bf16_t;
typedef short bf16x8 __attribute__((ext_vector_type(8)));
typedef float f32x4 __attribute__((ext_vector_type(4)));

struct Params {
  const float *x_prompt, *x_sample, *cache_k, *cache_v, *st_s5_re, *st_s5_im, *st_lru, *c, *c_ctx;
  const float *w_ada, *b_ada, *g1, *g2, *w_in, *rpb;
  const float *s5_lam_re, *s5_lam_im, *s5_log_step, *s5_b_re, *s5_b_im, *s5_c_re, *s5_c_im, *s5_d, *s5_w_glu;
  const float *lru_conv_w, *lru_conv_b, *lru_w_a, *lru_b_a, *lru_w_x, *lru_b_x, *lru_lam;
  const float *w_br_attn, *w_br_s5, *w_br_lru, *w_out, *ffn_w_up, *ffn_conv_w, *ffn_conv_b, *ffn_w_down, *g_final;
  float* out;
  char* ws;
};

#define OUT_NEWK 16777216
#define OUT_NEWV 25165824
#define OUT_S5RE 33554432
#define OUT_S5IM 33685504
#define OUT_LRU 33816576

#define WS_MOD 0
#define WS_WT 524288
#define WT_IN 0
#define WT_BRA 5505024
#define WT_BRS 6029312
#define WT_BRL 6291456
#define WT_OUT 6553600
#define WT_UP 7602176
#define WT_DOWN 13369344
#define WT_GLU 16252928
#define WT_LRU 16318464
#define WS_HBUF 33685504
#define WS_UB 67239936
#define UB_QB 0
#define UB_KB 16777216
#define UB_VTC 33554432
#define UB_VTL 41943040
#define UB_U 50331648
#define UB_XR 58720256
#define UB_XG 67108864
#define UB_S5Y 75497472
#define UB_LRUY 83886080
#define UB_MG 92274688
#define UB_KC 125829120
#define UB_VCT 130023424
#define UB_G8 134217728
#define UB_FA 0
#define UB_ACT 92274688
#define LDS_BYTES 132160
#ifndef PHASE_MASK
#define PHASE_MASK 0xffff
#endif
#define GSYNC() do { xcd_barrier(xb); if ((REP_MASK >> 14) & 1) xcd_barrier(xb); } while (0)
#ifndef REP_MASK
#define REP_MASK 0
#endif
#define PH(k) for (int rep_ = 0; rep_ < ((REP_MASK >> (k)) & 1) + 1; ++rep_) if (PHASE_MASK & (1 << (k)))
#define LAUNDER_TID() int tid = threadIdx.x; asm volatile("" : "+v"(tid)); const int lane = tid & 63, wave = tid >> 6, l15 = lane & 15, quad = lane >> 4; (void)lane; (void)wave; (void)l15; (void)quad

__device__ __forceinline__ uint32_t pack2(float a, float b) {
  uint32_t r;
  asm("v_cvt_pk_bf16_f32 %0, %1, %2" : "=v"(r) : "v"(a), "v"(b));
  return r;
}
__device__ __forceinline__ bf16_t f2bf(float f) { return (bf16_t)(pack2(f, 0.f) & 0xffffu); }
__device__ __forceinline__ float bf2f(bf16_t b) { return __uint_as_float(((uint32_t)b) << 16); }
__device__ __forceinline__ float lo2f(uint32_t u) { return __uint_as_float(u << 16); }
__device__ __forceinline__ float hi2f(uint32_t u) { return __uint_as_float(u & 0xffff0000u); }
__device__ __forceinline__ float sigmoidf_(float x) { return __builtin_amdgcn_rcpf(1.f + __expf(-x)); }
__device__ __forceinline__ float gelu_(float x) {
  float z = 0.7978845608028654f * (x + 0.044715f * x * x * x);
  float t = 1.f - 2.f * __builtin_amdgcn_rcpf(1.f + __expf(2.f * z));
  return 0.5f * x * (1.f + t);
}
__device__ __forceinline__ float quad_max(float x) {
  unsigned u = __float_as_uint(x);
  auto r = __builtin_amdgcn_permlane32_swap(u, u, false, false);
  float m = fmaxf(__uint_as_float(r[0]), __uint_as_float(r[1]));
  unsigned u2 = __float_as_uint(m);
  auto r2 = __builtin_amdgcn_permlane16_swap(u2, u2, false, false);
  return fmaxf(__uint_as_float(r2[0]), __uint_as_float(r2[1]));
}
__device__ __forceinline__ float quad_sum(float x) {
  unsigned u = __float_as_uint(x);
  auto r = __builtin_amdgcn_permlane32_swap(u, u, false, false);
  float m = __uint_as_float(r[0]) + __uint_as_float(r[1]);
  unsigned u2 = __float_as_uint(m);
  auto r2 = __builtin_amdgcn_permlane16_swap(u2, u2, false, false);
  return __uint_as_float(r2[0]) + __uint_as_float(r2[1]);
}
typedef float f32x4nt __attribute__((ext_vector_type(4)));
__device__ __forceinline__ float4 ld_nt4(const float* p) {
  f32x4nt v = __builtin_nontemporal_load((const f32x4nt*)p);
  return make_float4(v[0], v[1], v[2], v[3]);
}
__device__ __forceinline__ int modrow(int r) { return r < 8192 ? 0 : 1 + ((r - 8192) >> 10); }


#define WS_BAR 458752
#define XB_TMO      128
#define XB_XCNT(j)  (256  + 64 * (j))
#define XB_XSUB(j)  (1280 + 64 * (j))
#define XB_XGEN(j)  (2304 + 64 * (j))
#define XB_TOP      3328
#define XB_TOPGEN   3392
#define XB_WQ(i)    (3456 + 64 * (i))
#define XCD_BAR_WORDS 4096
#define XB_SPIN_CAP (1u << 18)
__device__ __forceinline__ unsigned xb_ld(unsigned* p) { return __hip_atomic_load(p, __ATOMIC_RELAXED, __HIP_MEMORY_SCOPE_AGENT); }
__device__ __forceinline__ unsigned xb_add(unsigned* p, unsigned v) { return __hip_atomic_fetch_add(p, v, __ATOMIC_RELAXED, __HIP_MEMORY_SCOPE_AGENT); }
__device__ __forceinline__ unsigned xb_xcc_id() { return (unsigned)__builtin_amdgcn_s_getreg((3 << 11) | 20) & 0xFu; }
#define XB_SPIN(cond, bar) do { unsigned _sp = 0; while (cond) { __builtin_amdgcn_s_sleep(1); \
    if ((++_sp & 255u) == 0u) { if (xb_ld(&(bar)[XB_TMO])) break; if (_sp > XB_SPIN_CAP) { atomicAdd(&(bar)[XB_TMO], 1u); break; } } } } while (0)
struct XcdBarrier { unsigned* bar; unsigned x; volatile LAS unsigned* st; };
__device__ __forceinline__ XcdBarrier xcd_barrier_post(unsigned* bar, volatile LAS unsigned* st) {
  XcdBarrier b; b.bar = bar; b.x = xb_xcc_id(); b.st = st;
  if (threadIdx.x == 0) (void)xb_add(&bar[XB_XCNT(b.x)], 1u);
  return b;
}
__device__ __forceinline__ void xcd_barrier_complete(unsigned* bar, unsigned x, unsigned& nloc, unsigned& nx) {
  const unsigned G = gridDim.x * gridDim.y * gridDim.z;
  unsigned sum, cnt, mine, sp = 0u;
  for (;;) {
    sum = 0u; cnt = 0u; mine = 0u;
#pragma unroll
    for (unsigned j = 0; j < 16; ++j) { const unsigned c = xb_ld(&bar[XB_XCNT(j)]); sum += c; cnt += (c > 0u) ? 1u : 0u; mine = (j == x) ? c : mine; }
    if (sum == G) break;
    __builtin_amdgcn_s_sleep(1);
    if ((++sp & 255u) == 0u) { if (xb_ld(&bar[XB_TMO])) break; if (sp > XB_SPIN_CAP) { atomicAdd(&bar[XB_TMO], 1u); break; } }
  }
  nloc = mine > 0u ? mine : 1u; nx = cnt > 0u ? cnt : 1u;
}
__device__ __forceinline__ void xcd_barrier(const XcdBarrier& b) {
  asm volatile("s_waitcnt vmcnt(0)" ::: "memory");
  __syncthreads();
  if (threadIdx.x == 0) {
    unsigned* bar = b.bar;
    __builtin_amdgcn_s_waitcnt(0);
    unsigned nloc = b.st[0], nx = b.st[1];
    if (nloc == 0u) { xcd_barrier_complete(bar, b.x, nloc, nx); b.st[0] = nloc; b.st[1] = nx; }
    const unsigned old = xb_add(&bar[XB_XSUB(b.x)], 1u);
    const unsigned gen = old / nloc;
    if (old + 1u == (gen + 1u) * nloc) {
      __builtin_amdgcn_fence(__ATOMIC_RELEASE, "agent");
      asm volatile("s_waitcnt vmcnt(0)" ::: "memory");
      const unsigned og = xb_add(&bar[XB_TOP], 1u);
      const unsigned tg = og / nx;
      if (og + 1u == (tg + 1u) * nx) xb_add(&bar[XB_TOPGEN], 1u);
      else XB_SPIN(xb_ld(&bar[XB_TOPGEN]) == tg, bar);
      __builtin_amdgcn_fence(__ATOMIC_ACQUIRE, "agent");
      xb_add(&bar[XB_XGEN(b.x)], 1u);
      asm volatile("s_waitcnt vmcnt(0)" ::: "memory");
    } else {
      XB_SPIN(xb_ld(&bar[XB_XGEN(b.x)]) == gen, bar);
      __builtin_amdgcn_fence(__ATOMIC_ACQUIRE, "agent");
      asm volatile("s_waitcnt vmcnt(0)" ::: "memory");
    }
  }
  __syncthreads();
}

namespace pg8 {
constexpr int BM = 256, BK = 64, HALF = 128, HTB = HALF * BK * 2, NXCD = 8, WGM = 8;
__device__ __forceinline__ int lds_byte(int r, int c) { const int st = (r >> 4) * 2 + (c >> 5), rr = r & 15, cc = c & 31, ob = rr * 64 + cc * 2; return st * 1024 + (ob ^ (((ob >> 9) & 1) << 5)); }
__device__ __forceinline__ void stage_rc(int b, int& R, int& C) { const int st = b / 1024, sb = b % 1024, swz = sb ^ (((sb >> 9) & 1) << 5); R = (st >> 1) * 16 + swz / 64; C = (st & 1) * 32 + (swz % 64) / 2; }
struct Unit { int pm, pn; };
struct Gemm { const bf16_t* A; const bf16_t* Bt; int lda, ldb, K; };
struct StaticOrder {
  int nM, nN, nwg, G, c;
  __device__ void init(int M, int N, int G_, int c_) { nM = M / BM; nN = N / BM; nwg = nM * nN; G = G_; c = c_; }
  __device__ bool next(int i, Unit& u) const {
    const long L = (long)i * G + c; if (L >= nwg) return false;
    int wgid = (int)L; { const int q = nwg / NXCD, r = nwg % NXCD, xcd = wgid % NXCD, off = wgid / NXCD; wgid = (xcd < r ? xcd * (q + 1) : r * (q + 1) + (xcd - r) * q) + off; }
    const int nig = WGM * nN, gid = wgid / nig, fm = gid * WGM, gsz = (nM - fm) < WGM ? (nM - fm) : WGM;
    u.pm = fm + ((wgid % nig) % gsz); u.pn = (wgid % nig) / gsz; return true;
  }
};

template <class Epi>
__device__ __forceinline__ void gemm_phase(LAS unsigned char* lds, const Gemm g, const StaticOrder& S, const Epi& E) {
  int tid = threadIdx.x; asm volatile("" : "+v"(tid));
  const int wid = __builtin_amdgcn_readfirstlane(tid >> 6), lane = tid & 63, wr = wid >> 2, wc = wid & 3, fr = lane & 15, fq = lane >> 4;
  const int K = g.K, nt = K / BK;
  unsigned voffA[2], voffB[2];
#pragma unroll
  for (int i = 0; i < 2; ++i) { int R, C; stage_rc(tid * 16 + i * 8192, R, C);
    voffA[i] = (unsigned)(R * g.lda + C) * 2u; voffB[i] = (unsigned)(R * g.ldb + C) * 2u; }
  asm volatile("" : "+v"(voffA[0]), "+v"(voffA[1]), "+v"(voffB[0]), "+v"(voffB[1]));
  const size_t kstep = (size_t)(BK * 2);
  const size_t hstepA = (size_t)HALF * g.lda * 2, hstepB = (size_t)HALF * g.ldb * 2;
  const size_t tstepA = 2 * hstepA, tstepB = 2 * hstepB;
  const unsigned ldsw = (unsigned)wid * 1024u;
  const int aoff = lds_byte(wr * 64 + fr, fq * 8), boff = lds_byte(wc * 32 + fr, fq * 8);
#define PG8_SA(b, h) (((b) * 2 + (h)) * HTB)
#define PG8_SB(b, h) ((4 + (b) * 2 + (h)) * HTB)
#define PG8_STAGE(bufoff, gbase, voff) do { _Pragma("unroll") for (int _i = 0; _i < 2; ++_i) \
    __builtin_amdgcn_global_load_lds((const unsigned*)((const char*)(gbase) + (voff)[_i]), (LAS unsigned*)(lds + (bufoff) + ldsw + _i * 8192), 16, 0, 0); } while (0)
#define PG8_LDA(dst, b, h) do { _Pragma("unroll") for (int m = 0; m < 4; ++m) _Pragma("unroll") for (int k = 0; k < 2; ++k) dst[m][k] = *(const LAS bf16x8*)(lds + PG8_SA(b, h) + aoff + m * 2048 + k * 1024); } while (0)
#define PG8_LDB(dst, b, h) do { _Pragma("unroll") for (int n = 0; n < 2; ++n) _Pragma("unroll") for (int k = 0; k < 2; ++k) dst[n][k] = *(const LAS bf16x8*)(lds + PG8_SB(b, h) + boff + n * 2048 + k * 1024); } while (0)
#define PG8_MMA(ai, bj, At, Bt) do { __builtin_amdgcn_s_setprio(1); _Pragma("unroll") for (int m = 0; m < 4; ++m) _Pragma("unroll") for (int n = 0; n < 2; ++n) _Pragma("unroll") for (int k = 0; k < 2; ++k) \
    acc[ai][bj][m][n] = __builtin_amdgcn_mfma_f32_16x16x32_bf16(Bt[n][k], At[m][k], acc[ai][bj][m][n], 0, 0, 0); __builtin_amdgcn_s_setprio(0); } while (0)
#define PG8_WAIT_V(n) asm volatile("s_waitcnt vmcnt(" #n ")" ::: "memory")
#define PG8_WAIT_L(n) asm volatile("s_waitcnt lgkmcnt(" #n ")" ::: "memory")
#define PG8_BAR __builtin_amdgcn_s_barrier()
#define PG8_SCHED __builtin_amdgcn_sched_barrier(0)
  Unit cur, nxt; int ui = 0;
  if (!S.next(0, cur)) return;
  f32x4 acc[2][2][4][2];
#pragma unroll
  for (int a = 0; a < 2; ++a)
#pragma unroll
    for (int b = 0; b < 2; ++b)
#pragma unroll
      for (int m = 0; m < 4; ++m)
#pragma unroll
        for (int n = 0; n < 2; ++n) acc[a][b][m][n] = (f32x4){0.f, 0.f, 0.f, 0.f};
  bf16x8 At[4][2], B0[2][2], B1[2][2];
  const char* cA = (const char*)g.A + (size_t)cur.pm * tstepA; const char* cB = (const char*)g.Bt + (size_t)cur.pn * tstepB;
  PG8_STAGE(PG8_SB(0, 0), cB, voffB); PG8_STAGE(PG8_SA(0, 0), cA, voffA); PG8_STAGE(PG8_SB(0, 1), cB + hstepB, voffB); PG8_STAGE(PG8_SA(0, 1), cA + hstepA, voffA);
  if (wr == 1) PG8_BAR;
  PG8_WAIT_V(4); PG8_BAR;
  PG8_STAGE(PG8_SB(1, 0), cB + kstep, voffB); PG8_STAGE(PG8_SA(1, 0), cA + kstep, voffA); PG8_STAGE(PG8_SB(1, 1), cB + hstepB + kstep, voffB);
  PG8_WAIT_V(6); PG8_BAR;
  for (;;) {
    const bool has_next = S.next(ui + 1, nxt);
    const char* nA = has_next ? (const char*)g.A + (size_t)nxt.pm * tstepA : cA; const char* nB = has_next ? (const char*)g.Bt + (size_t)nxt.pn * tstepB : cB;
    for (int t = 0; t < nt; t += 2) {
      const bool last = (t == nt - 2);
      const char* a1 = cA + (size_t)(t + 1) * kstep;
      const char* a2 = last ? nA : cA + (size_t)(t + 2) * kstep; const char* b2 = last ? nB : cB + (size_t)(t + 2) * kstep;
      const char* a3 = a2 + kstep; const char* b3 = b2 + kstep;
      PG8_LDB(B0, 0, 0); PG8_SCHED; PG8_LDA(At, 0, 0); PG8_STAGE(PG8_SA(1, 1), a1 + hstepA, voffA);
      PG8_WAIT_L(8); PG8_BAR; PG8_WAIT_L(0); PG8_MMA(0, 0, At, B0); PG8_BAR; PG8_SCHED;
      PG8_LDB(B1, 0, 1); PG8_STAGE(PG8_SB(0, 0), b2, voffB);
      PG8_BAR; PG8_WAIT_L(0); PG8_MMA(0, 1, At, B1); PG8_BAR;
      PG8_LDA(At, 0, 1); PG8_STAGE(PG8_SA(0, 0), a2, voffA);
      PG8_BAR; PG8_WAIT_L(0); PG8_MMA(1, 0, At, B0); PG8_BAR; PG8_SCHED;
      PG8_STAGE(PG8_SB(0, 1), b2 + hstepB, voffB);
      PG8_WAIT_V(6); PG8_BAR; PG8_MMA(1, 1, At, B1); PG8_BAR;
      PG8_LDB(B0, 1, 0); PG8_SCHED; PG8_LDA(At, 1, 0); PG8_STAGE(PG8_SA(0, 1), a2 + hstepA, voffA);
      PG8_WAIT_L(8); PG8_BAR; PG8_WAIT_L(0); PG8_MMA(0, 0, At, B0); PG8_BAR; PG8_SCHED;
      PG8_LDB(B1, 1, 1); PG8_STAGE(PG8_SB(1, 0), b3, voffB);
      PG8_BAR; PG8_WAIT_L(0); PG8_MMA(0, 1, At, B1); PG8_BAR;
      PG8_LDA(At, 1, 1); PG8_STAGE(PG8_SA(1, 0), a3, voffA);
      PG8_BAR; PG8_WAIT_L(0); PG8_MMA(1, 0, At, B0); PG8_BAR; PG8_SCHED;
      PG8_STAGE(PG8_SB(1, 1), b3 + hstepB, voffB);
      PG8_WAIT_V(6); PG8_BAR; PG8_MMA(1, 1, At, B1); PG8_BAR;
    }
    E(acc, cur, wr, wc, fr, fq);
    if (!has_next) break;
#pragma unroll
    for (int a = 0; a < 2; ++a)
#pragma unroll
      for (int b = 0; b < 2; ++b)
#pragma unroll
        for (int m = 0; m < 4; ++m)
#pragma unroll
          for (int n = 0; n < 2; ++n) acc[a][b][m][n] = (f32x4){0.f, 0.f, 0.f, 0.f};
    cur = nxt; cA = nA; cB = nB; ++ui;
  }
  PG8_WAIT_V(0);
  if (wr == 0) PG8_BAR;
  PG8_BAR;
#undef PG8_SA
#undef PG8_SB
#undef PG8_STAGE
#undef PG8_LDA
#undef PG8_LDB
#undef PG8_MMA
#undef PG8_WAIT_V
#undef PG8_WAIT_L
#undef PG8_BAR
#undef PG8_SCHED
}


template <class Epi>
__device__ __forceinline__ void gemm_phase_seg(LAS unsigned char* lds, const bf16_t* A0, const bf16_t* A1, const bf16_t* A2,
                                               const bf16_t* Bt0, const bf16_t* Bt1, const bf16_t* Bt2, int K0, int K12, const StaticOrder& S, const Epi& E) {
  int tid = threadIdx.x; asm volatile("" : "+v"(tid));
  const int wid = __builtin_amdgcn_readfirstlane(tid >> 6), lane = tid & 63, wr = wid >> 2, wc = wid & 3, fr = lane & 15, fq = lane >> 4;
  unsigned Rv[2], C2[2];
#pragma unroll
  for (int i = 0; i < 2; ++i) { int R, C; stage_rc(tid * 16 + i * 8192, R, C); Rv[i] = (unsigned)R; C2[i] = (unsigned)C * 2u; }
  asm volatile("" : "+v"(Rv[0]), "+v"(Rv[1]), "+v"(C2[0]), "+v"(C2[1]));
  const size_t kstep = (size_t)(BK * 2);
  const unsigned ldsw = (unsigned)wid * 1024u;
  const int aoff = lds_byte(wr * 64 + fr, fq * 8), boff = lds_byte(wc * 32 + fr, fq * 8);
#define PG8_SA(b, h) (((b) * 2 + (h)) * HTB)
#define PG8_SB(b, h) ((4 + (b) * 2 + (h)) * HTB)
#define PG8_STAGE(bufoff, gbase, ld2) do { _Pragma("unroll") for (int _i = 0; _i < 2; ++_i) \
    __builtin_amdgcn_global_load_lds((const unsigned*)((const char*)(gbase) + (Rv[_i] * (unsigned)(ld2) + C2[_i])), (LAS unsigned*)(lds + (bufoff) + ldsw + _i * 8192), 16, 0, 0); } while (0)
#define PG8_LDA(dst, b, h) do { _Pragma("unroll") for (int m = 0; m < 4; ++m) _Pragma("unroll") for (int k = 0; k < 2; ++k) dst[m][k] = *(const LAS bf16x8*)(lds + PG8_SA(b, h) + aoff + m * 2048 + k * 1024); } while (0)
#define PG8_LDB(dst, b, h) do { _Pragma("unroll") for (int n = 0; n < 2; ++n) _Pragma("unroll") for (int k = 0; k < 2; ++k) dst[n][k] = *(const LAS bf16x8*)(lds + PG8_SB(b, h) + boff + n * 2048 + k * 1024); } while (0)
#define PG8_MMA(ai, bj, At, Bt) do { __builtin_amdgcn_s_setprio(1); _Pragma("unroll") for (int m = 0; m < 4; ++m) _Pragma("unroll") for (int n = 0; n < 2; ++n) _Pragma("unroll") for (int k = 0; k < 2; ++k) \
    acc[ai][bj][m][n] = __builtin_amdgcn_mfma_f32_16x16x32_bf16(Bt[n][k], At[m][k], acc[ai][bj][m][n], 0, 0, 0); __builtin_amdgcn_s_setprio(0); } while (0)
#define PG8_WAIT_V(n) asm volatile("s_waitcnt vmcnt(" #n ")" ::: "memory")
#define PG8_WAIT_L(n) asm volatile("s_waitcnt lgkmcnt(" #n ")" ::: "memory")
#define PG8_BAR __builtin_amdgcn_s_barrier()
#define PG8_SCHED __builtin_amdgcn_sched_barrier(0)
  Unit cur, nxt; int ui = 0; int cseg = 0;
  if (!S.next(0, cur)) return;
  f32x4 acc[2][2][4][2];
#pragma unroll
  for (int a = 0; a < 2; ++a)
#pragma unroll
    for (int b = 0; b < 2; ++b)
#pragma unroll
      for (int m = 0; m < 4; ++m)
#pragma unroll
        for (int n = 0; n < 2; ++n) acc[a][b][m][n] = (f32x4){0.f, 0.f, 0.f, 0.f};
  bf16x8 At[4][2], B0[2][2], B1[2][2];
  int cK = K0;
  unsigned ld2 = (unsigned)cK * 2u;
  size_t hstep = (size_t)HALF * ld2;
  const char* cA = (const char*)A0 + (size_t)cur.pm * 2 * hstep; const char* cB = (const char*)Bt0 + (size_t)cur.pn * 2 * hstep;
  PG8_STAGE(PG8_SB(0, 0), cB, ld2); PG8_STAGE(PG8_SA(0, 0), cA, ld2); PG8_STAGE(PG8_SB(0, 1), cB + hstep, ld2); PG8_STAGE(PG8_SA(0, 1), cA + hstep, ld2);
  if (wr == 1) PG8_BAR;
  PG8_WAIT_V(4); PG8_BAR;
  PG8_STAGE(PG8_SB(1, 0), cB + kstep, ld2); PG8_STAGE(PG8_SA(1, 0), cA + kstep, ld2); PG8_STAGE(PG8_SB(1, 1), cB + hstep + kstep, ld2);
  PG8_WAIT_V(6); PG8_BAR;
  for (;;) {
    int nseg = cseg + 1; bool has_next = true; nxt = cur;
    if (nseg == 3) { nseg = 0; has_next = S.next(ui + 1, nxt); }
    const int nK = has_next ? (nseg == 0 ? K0 : K12) : cK;
    const unsigned nld2 = (unsigned)nK * 2u;
    const size_t nhstep = (size_t)HALF * nld2;
    const bf16_t* nAb = nseg == 0 ? A0 : (nseg == 1 ? A1 : A2);
    const bf16_t* nBb = nseg == 0 ? Bt0 : (nseg == 1 ? Bt1 : Bt2);
    const char* nA = has_next ? (const char*)nAb + (size_t)nxt.pm * 2 * nhstep : cA;
    const char* nB = has_next ? (const char*)nBb + (size_t)nxt.pn * 2 * nhstep : cB;
    const int nt = cK / BK;
    for (int t = 0; t < nt; t += 2) {
      const bool last = (t == nt - 2);
      const char* a1 = cA + (size_t)(t + 1) * kstep;
      const char* a2 = last ? nA : cA + (size_t)(t + 2) * kstep; const char* b2 = last ? nB : cB + (size_t)(t + 2) * kstep;
      const char* a3 = a2 + kstep; const char* b3 = b2 + kstep;
      const unsigned l2 = last ? nld2 : ld2; const size_t h2 = last ? nhstep : hstep;
      PG8_LDB(B0, 0, 0); PG8_SCHED; PG8_LDA(At, 0, 0); PG8_STAGE(PG8_SA(1, 1), a1 + hstep, ld2);
      PG8_WAIT_L(8); PG8_BAR; PG8_WAIT_L(0); PG8_MMA(0, 0, At, B0); PG8_BAR; PG8_SCHED;
      PG8_LDB(B1, 0, 1); PG8_STAGE(PG8_SB(0, 0), b2, l2);
      PG8_BAR; PG8_WAIT_L(0); PG8_MMA(0, 1, At, B1); PG8_BAR;
      PG8_LDA(At, 0, 1); PG8_STAGE(PG8_SA(0, 0), a2, l2);
      PG8_BAR; PG8_WAIT_L(0); PG8_MMA(1, 0, At, B0); PG8_BAR; PG8_SCHED;
      PG8_STAGE(PG8_SB(0, 1), b2 + h2, l2);
      PG8_WAIT_V(6); PG8_BAR; PG8_MMA(1, 1, At, B1); PG8_BAR;
      PG8_LDB(B0, 1, 0); PG8_SCHED; PG8_LDA(At, 1, 0); PG8_STAGE(PG8_SA(0, 1), a2 + h2, l2);
      PG8_WAIT_L(8); PG8_BAR; PG8_WAIT_L(0); PG8_MMA(0, 0, At, B0); PG8_BAR; PG8_SCHED;
      PG8_LDB(B1, 1, 1); PG8_STAGE(PG8_SB(1, 0), b3, l2);
      PG8_BAR; PG8_WAIT_L(0); PG8_MMA(0, 1, At, B1); PG8_BAR;
      PG8_LDA(At, 1, 1); PG8_STAGE(PG8_SA(1, 0), a3, l2);
      PG8_BAR; PG8_WAIT_L(0); PG8_MMA(1, 0, At, B0); PG8_BAR; PG8_SCHED;
      PG8_STAGE(PG8_SB(1, 1), b3 + h2, l2);
      PG8_WAIT_V(6); PG8_BAR; PG8_MMA(1, 1, At, B1); PG8_BAR;
    }
    E(acc, cur, cseg, wr, wc, fr, fq);
    if (!has_next) break;
    if (nseg == 0) {
#pragma unroll
      for (int a = 0; a < 2; ++a)
#pragma unroll
        for (int b = 0; b < 2; ++b)
#pragma unroll
          for (int m = 0; m < 4; ++m)
#pragma unroll
            for (int n = 0; n < 2; ++n) acc[a][b][m][n] = (f32x4){0.f, 0.f, 0.f, 0.f};
      ++ui;
    }
    cur = nxt; cA = nA; cB = nB; cseg = nseg; cK = nK; ld2 = nld2; hstep = nhstep;
  }
  PG8_WAIT_V(0);
  if (wr == 0) PG8_BAR;
  PG8_BAR;
#undef PG8_SA
#undef PG8_SB
#undef PG8_STAGE
#undef PG8_LDA
#undef PG8_LDB
#undef PG8_MMA
#undef PG8_WAIT_V
#undef PG8_WAIT_L
#undef PG8_BAR
#undef PG8_SCHED
}

template <class FL, class FA> struct EpiSeg {
  FL ld; FA ap;
  __device__ __forceinline__ void operator()(f32x4 (&acc)[2][2][4][2], const Unit& u, int seg, int wr, int wc, int fr, int fq) const {
    asm volatile("" : "+v"(fr), "+v"(fq));
    uint2 g[2][4][2][2];
#pragma unroll
    for (int ai = 0; ai < 2; ++ai)
#pragma unroll
      for (int m = 0; m < 4; ++m) {
        const int row = u.pm * BM + ai * HALF + wr * 64 + m * 16 + fr;
#pragma unroll
        for (int bj = 0; bj < 2; ++bj)
#pragma unroll
          for (int n = 0; n < 2; ++n) g[ai][m][bj][n] = ld(row, u.pn * BM + bj * HALF + wc * 32 + n * 16 + 4 * fq, seg);
      }
#pragma unroll
    for (int ai = 0; ai < 2; ++ai)
#pragma unroll
      for (int m = 0; m < 4; ++m) {
        const int row = u.pm * BM + ai * HALF + wr * 64 + m * 16 + fr;
#pragma unroll
        for (int bj = 0; bj < 2; ++bj)
#pragma unroll
          for (int n = 0; n < 2; ++n) ap(row, u.pn * BM + bj * HALF + wc * 32 + n * 16 + 4 * fq, acc[ai][bj][m][n], seg, g[ai][m][bj][n]);
      }
  }
};
template <class FL, class FA> __device__ __forceinline__ EpiSeg<FL, FA> make_epi_seg(FL l, FA a) { return EpiSeg<FL, FA>{l, a}; }

template <class F> struct EpiL {
  F f;
  __device__ __forceinline__ void operator()(const f32x4 (&acc)[2][2][4][2], const Unit& u, int wr, int wc, int fr, int fq) const {
    asm volatile("" : "+v"(fr), "+v"(fq));
#pragma unroll
    for (int ai = 0; ai < 2; ++ai)
#pragma unroll
      for (int m = 0; m < 4; ++m) {
        const int row = u.pm * BM + ai * HALF + wr * 64 + m * 16 + fr;
#pragma unroll
        for (int bj = 0; bj < 2; ++bj)
#pragma unroll
          for (int n = 0; n < 2; ++n) f(row, u.pn * BM + bj * HALF + wc * 32 + n * 16 + 4 * fq, acc[ai][bj][m][n]);
        asm volatile("" ::: "memory");
      }
  }
};
template <class F> __device__ __forceinline__ EpiL<F> make_epi(F f) { return EpiL<F>{f}; }
}

template <class F>
__device__ __forceinline__ void run_gemm(LAS unsigned char* lds, const bf16_t* A, int lda, const bf16_t* Bt, int ldb, int N, int K, F f, int boff = 0) {
  asm volatile("" : "+s"(K), "+s"(lda), "+s"(ldb));
  pg8::StaticOrder S; S.init(16384, N, gridDim.x, (int)((blockIdx.x + (unsigned)boff) % gridDim.x));
  pg8::Gemm g{A, Bt, lda, ldb, K};
  pg8::gemm_phase(lds, g, S, pg8::make_epi(f));
}

__device__ __forceinline__ void transpose_tile(const float* __restrict__ src, int lds_, bf16_t* __restrict__ dst, int ldd, float* tile, int tid) {
#pragma unroll
  for (int i = 0; i < 2; ++i) {
    int idx = tid + i * 512;
    int r = idx >> 4, c4 = (idx & 15) * 4;
    float4 v = ld_nt4(src + (size_t)r * lds_ + c4);
    *(float4*)(tile + r * 68 + c4) = v;
  }
  __syncthreads();
  {
    int n = tid & 63, k0 = (tid >> 6) * 8;
    const float* tp = tile + k0 * 68 + n;
    uint4 o;
    o.x = pack2(tp[0], tp[68]); o.y = pack2(tp[136], tp[204]); o.z = pack2(tp[272], tp[340]); o.w = pack2(tp[408], tp[476]);
    *(uint4*)(dst + (size_t)n * ldd + k0) = o;
  }
  __syncthreads();
}

__device__ __forceinline__ void convert_layer(const Params& p, int l, float* tile, int tid) {
  asm volatile("" : "+v"(tid));
  bf16_t* WT = (bf16_t*)(p.ws + WS_WT);
  bf16_t* VCT = (bf16_t*)(p.ws + WS_UB + UB_VCT);
  bf16_t* KC = (bf16_t*)(p.ws + WS_UB + UB_KC);
  for (int ti0 = blockIdx.x; ti0 < 4496; ti0 += gridDim.x) {
    int ti = ti0;
    const float* src; int lds_; bf16_t* dst; int ldd;
    if (ti < 1344) {
      int kt = ti / 84, nt = ti % 84;
      src = p.w_in + (size_t)l * 1024 * 5376 + (size_t)kt * 64 * 5376 + nt * 64; lds_ = 5376;
      int nrow = nt * 64; nrow = nrow < 2048 ? nrow : (nrow < 2304 ? nrow + 3072 : nrow - 256);
      dst = WT + WT_IN + (size_t)nrow * 1024 + kt * 64; ldd = 1024;
    } else if ((ti -= 1344) < 128) {
      int kt = ti / 16, nt = ti % 16;
      src = p.w_br_attn + (size_t)l * 512 * 1024 + (size_t)kt * 64 * 1024 + nt * 64; lds_ = 1024;
      dst = WT + WT_BRA + (size_t)nt * 64 * 512 + kt * 64; ldd = 512;
    } else if ((ti -= 128) < 64) {
      int kt = ti / 16, nt = ti % 16;
      src = p.w_br_s5 + (size_t)l * 256 * 1024 + (size_t)kt * 64 * 1024 + nt * 64; lds_ = 1024;
      dst = WT + WT_BRS + (size_t)nt * 64 * 256 + kt * 64; ldd = 256;
    } else if ((ti -= 64) < 64) {
      int kt = ti / 16, nt = ti % 16;
      src = p.w_br_lru + (size_t)l * 256 * 1024 + (size_t)kt * 64 * 1024 + nt * 64; lds_ = 1024;
      dst = WT + WT_BRL + (size_t)nt * 64 * 256 + kt * 64; ldd = 256;
    } else if ((ti -= 64) < 256) {
      int kt = ti / 16, nt = ti % 16;
      src = p.w_out + (size_t)l * 1024 * 1024 + (size_t)kt * 64 * 1024 + nt * 64; lds_ = 1024;
      dst = WT + WT_OUT + (size_t)nt * 64 * 1024 + kt * 64; ldd = 1024;
    } else if ((ti -= 256) < 1408) {
      int kt = ti / 88, nt = ti % 88;
      src = p.ffn_w_up + (size_t)l * 1024 * 5632 + (size_t)kt * 64 * 5632 + nt * 64; lds_ = 5632;
      dst = WT + WT_UP + (size_t)nt * 64 * 1024 + kt * 64; ldd = 1024;
    } else if ((ti -= 1408) < 704) {
      int kt = ti / 16, nt = ti % 16;
      src = p.ffn_w_down + (size_t)l * 2816 * 1024 + (size_t)kt * 64 * 1024 + nt * 64; lds_ = 1024;
      dst = WT + WT_DOWN + (size_t)nt * 64 * 2816 + kt * 64; ldd = 2816;
    } else if ((ti -= 704) < 16) {
      int kt = ti / 4, nt = ti % 4;
      src = p.s5_w_glu + (size_t)l * 65536 + (size_t)kt * 64 * 256 + nt * 64; lds_ = 256;
      dst = WT + WT_GLU + (size_t)nt * 64 * 256 + kt * 64; ldd = 256;
    } else {
      ti -= 16;
      int ct = ti & 7, h = (ti >> 3) & 7, b = ti >> 6;
      src = p.cache_v + ((size_t)(b * 2 + l) * 512 + ct * 64) * 512 + h * 64; lds_ = 512;
      dst = VCT + (size_t)((b * 8 + h) * 64) * 512 + ct * 64; ldd = 512;
    }
    transpose_tile(src, lds_, dst, ldd, tile, tid);
  }
  for (int idx = blockIdx.x * 512 + tid; idx < 262144; idx += gridDim.x * 512) {
    int d8 = idx & 7, h = (idx >> 3) & 7, c = (idx >> 6) & 511, b = idx >> 15;
    const float* s = p.cache_k + ((size_t)((b * 2 + l) * 512 + c) * 8 + h) * 64 + d8 * 8;
    float4 v0 = ld_nt4(s), v1 = ld_nt4(s + 4);
    uint4 o;
    o.x = pack2(v0.x, v0.y); o.y = pack2(v0.z, v0.w); o.z = pack2(v1.x, v1.y); o.w = pack2(v1.z, v1.w);
    *(uint4*)(KC + ((size_t)((b * 8 + h) * 512 + c)) * 64 + d8 * 8) = o;
  }
  for (int idx = blockIdx.x * 512 + tid; idx < 262144; idx += gridDim.x * 512) {
    int n = idx >> 8, k = idx & 255;
    int dir = n >> 9, gate = (n >> 8) & 1, ch = n & 255;
    int blk = ch >> 6, j = ch & 63, kb = k >> 6, i = k & 63;
    float v = 0.f;
    if (kb == blk) v = (gate ? p.lru_w_x : p.lru_w_a)[(size_t)l * 32768 + ((size_t)(dir * 4 + blk) * 64 + i) * 64 + j];
    WT[WT_LRU + idx] = f2bf(v);
  }
}

__device__ __forceinline__ void norm_phase(const Params& p, int l, int which, bool from_inputs, int tid) {
  float* X = p.out;
  const float* MOD = (const float*)(p.ws + WS_MOD) + (size_t)l * 9 * 6144;
  bf16_t* H = (bf16_t*)(p.ws + WS_HBUF);
  const float* g = (which == 0 ? p.g1 : p.g2) + l * 1024;
  const int shoff = which == 0 ? 0 : 3072, scoff = which == 0 ? 1024 : 4096;
  asm volatile("" : "+v"(tid));
  const int lane = tid & 63, wave = tid >> 6;
  for (int r = blockIdx.x * 8 + wave; r < 16384; r += gridDim.x * 8) {
    const float* xr = from_inputs ? (r < 8192 ? p.x_prompt + (size_t)r * 1024 : p.x_sample + (size_t)(r - 8192) * 1024)
                                  : X + (size_t)r * 1024;
    float4 v[4];
    float ss = 0.f;
#pragma unroll
    for (int i = 0; i < 4; ++i) {
      v[i] = *(const float4*)(xr + i * 256 + lane * 4);
      ss += v[i].x * v[i].x + v[i].y * v[i].y + v[i].z * v[i].z + v[i].w * v[i].w;
    }
#pragma unroll
    for (int o = 32; o >= 1; o >>= 1) ss += __shfl_xor(ss, o);
    float rstd = rsqrtf(ss * (1.f / 1024.f) + 1e-6f);
    const float* mr = MOD + (size_t)modrow(r) * 6144;
#pragma unroll
    for (int i = 0; i < 4; ++i) {
      int c = i * 256 + lane * 4;
      float4 gg = *(const float4*)(g + c);
      float4 sc = *(const float4*)(mr + scoff + c);
      float4 sh = *(const float4*)(mr + shoff + c);
      float o0 = v[i].x * rstd * gg.x * (1.f + sc.x) + sh.x;
      float o1 = v[i].y * rstd * gg.y * (1.f + sc.y) + sh.y;
      float o2 = v[i].z * rstd * gg.z * (1.f + sc.z) + sh.z;
      float o3 = v[i].w * rstd * gg.w * (1.f + sc.w) + sh.w;
      uint2 o; o.x = pack2(o0, o1); o.y = pack2(o2, o3);
      *(uint2*)(H + (size_t)r * 1024 + c) = o;
    }
  }
}

struct AttnState {
  f32x4 o[4];
  float m, lsum;
};

__device__ __forceinline__ void attn_scores(const bf16_t* kb, int kld, const bf16x8 (&qf)[2], float (&s)[8], int l15, int quad) {
#pragma unroll
  for (int half = 0; half < 2; ++half) {
    const bf16_t* kp = kb + (size_t)(half * 16 + l15) * kld + quad * 8;
    bf16x8 a0 = *(const bf16x8*)kp;
    bf16x8 a1 = *(const bf16x8*)(kp + 32);
    f32x4 acc = {0.f, 0.f, 0.f, 0.f};
    acc = __builtin_amdgcn_mfma_f32_16x16x32_bf16(a0, qf[0], acc, 0, 0, 0);
    acc = __builtin_amdgcn_mfma_f32_16x16x32_bf16(a1, qf[1], acc, 0, 0, 0);
#pragma unroll
    for (int e = 0; e < 4; ++e) s[half * 4 + e] = acc[e];
  }
}

__device__ __forceinline__ void attn_update(AttnState& st, float (&s)[8], const bf16_t* vt, int vtld, int l15, int quad) {
  float tm = s[0];
#pragma unroll
  for (int i = 1; i < 8; ++i) tm = fmaxf(tm, s[i]);
  tm = fmaxf(tm, __shfl_xor(tm, 16));
  tm = fmaxf(tm, __shfl_xor(tm, 32));
  float mn = fmaxf(st.m, tm);
  float alpha = __expf(st.m - mn);
  st.m = mn;
  float pv[8];
  float ps = 0.f;
#pragma unroll
  for (int i = 0; i < 8; ++i) { pv[i] = __expf(s[i] - mn); ps += pv[i]; }
  st.lsum = st.lsum * alpha + ps;
  union { uint4 u; bf16x8 v; } pb;
  pb.u.x = pack2(pv[0], pv[1]); pb.u.y = pack2(pv[2], pv[3]); pb.u.z = pack2(pv[4], pv[5]); pb.u.w = pack2(pv[6], pv[7]);
#pragma unroll
  for (int db = 0; db < 4; ++db) {
    const bf16_t* vp = vt + (size_t)(db * 16 + l15) * vtld + quad * 4;
    uint2 lo = *(const uint2*)vp;
    uint2 hi = *(const uint2*)(vp + 16);
    union { uint4 u; bf16x8 v; } va;
    va.u.x = lo.x; va.u.y = lo.y; va.u.z = hi.x; va.u.w = hi.y;
    f32x4 o = st.o[db];
    o[0] *= alpha; o[1] *= alpha; o[2] *= alpha; o[3] *= alpha;
    st.o[db] = __builtin_amdgcn_mfma_f32_16x16x32_bf16(va.v, pb.v, o, 0, 0, 0);
  }
}

__device__ __forceinline__ void s5_disc(const Params& p, int l, int dir, int g, int n, float& lbr, float& lbi, float& cr, float& ci) {
  int li = ((l * 2 + dir) * 16 + g) * 64 + n;
  float lre = p.s5_lam_re[li], lim = p.s5_lam_im[li];
  float stp = expf(p.s5_log_step[(l * 2 + dir) * 16 + g]);
  float er = expf(lre * stp);
  float ang = lim * stp;
  lbr = er * cosf(ang); lbi = er * sinf(ang);
  float nr = lbr - 1.f, ni = lbi;
  float den = lre * lre + lim * lim;
  cr = (nr * lre + ni * lim) / den;
  ci = (ni * lre - nr * lim) / den;
}

#define S5_BUS 132
#define S5_HS 136
#define S5_WAVE_BYTES 12800

__global__ void __launch_bounds__(512, 2) mega(Params p) {
  cg::grid_group grid = cg::this_grid();
  extern __shared__ __attribute__((aligned(16))) unsigned char dyn_lds[];
  LAS unsigned char* lds = (LAS unsigned char*)dyn_lds;
  char* smem_raw = (char*)dyn_lds;
  const int tid = threadIdx.x;
  const int lane = tid & 63, wave = tid >> 6;
  const int l15 = lane & 15, quad = lane >> 4;

  volatile LAS unsigned* xb_st = (volatile LAS unsigned*)(lds + 132096);
  if (tid == 0) { xb_st[0] = 0u; xb_st[1] = 0u; }
  __syncthreads();
  unsigned* const BAR = (unsigned*)(p.ws + WS_BAR);
  const XcdBarrier xb = xcd_barrier_post(BAR, xb_st);

  char* const WSB = p.ws;
  float* const OUTB = p.out;
#define X OUTB
#define MODALL ((float*)(WSB + WS_MOD))
#define WT ((bf16_t*)(WSB + WS_WT))
#define HBUF ((bf16_t*)(WSB + WS_HBUF))
#define UB (WSB + WS_UB)
#define QB ((bf16_t*)(WSB + WS_UB + UB_QB))
#define KB ((bf16_t*)(WSB + WS_UB + UB_KB))
#define VTC ((bf16_t*)(WSB + WS_UB + UB_VTC))
#define VTL ((bf16_t*)(WSB + WS_UB + UB_VTL))
#define U ((bf16_t*)(WSB + WS_UB + UB_U))
#define XR ((bf16_t*)(WSB + WS_UB + UB_XR))
#define XG ((bf16_t*)(WSB + WS_UB + UB_XG))
#define S5Y ((bf16_t*)(WSB + WS_UB + UB_S5Y))
#define LRUY ((bf16_t*)(WSB + WS_UB + UB_LRUY))
#define MG ((bf16_t*)(WSB + WS_UB + UB_MG))
#define KC ((bf16_t*)(WSB + WS_UB + UB_KC))
#define VCT ((bf16_t*)(WSB + WS_UB + UB_VCT))
#define G8 ((unsigned char*)(WSB + WS_UB + UB_G8))

  {
    float* sc = (float*)smem_raw;
    float* red = sc + 9 * 1024;
    if (blockIdx.x < 384) {
      for (int i = tid; i < 9 * 1024; i += 512) {
        int m = i >> 10, k = i & 1023;
        float v = (m == 0) ? p.c_ctx[k] : p.c[(m - 1) * 1024 + k];
        sc[i] = v / (1.f + __expf(-v));
      }
      __syncthreads();
      for (int item = blockIdx.x; item < 384; item += gridDim.x) {
        int l = item / 192, n0 = (item % 192) * 32;
        int cs_ = tid & 31, ks = tid >> 5;
        float a0 = 0, a1 = 0, a2 = 0, a3 = 0, a4 = 0, a5 = 0, a6 = 0, a7 = 0, a8 = 0;
        const float* w = p.w_ada + (size_t)l * 1024 * 6144 + (size_t)(ks * 64) * 6144 + n0 + cs_;
        const float* s0 = sc + ks * 64;
#pragma unroll 8
        for (int k = 0; k < 64; ++k) {
          float wv = __builtin_nontemporal_load(w + (size_t)k * 6144);
          a0 += s0[k] * wv; a1 += s0[1024 + k] * wv; a2 += s0[2048 + k] * wv; a3 += s0[3072 + k] * wv;
          a4 += s0[4096 + k] * wv; a5 += s0[5120 + k] * wv; a6 += s0[6144 + k] * wv; a7 += s0[7168 + k] * wv;
          a8 += s0[8192 + k] * wv;
        }
        red[(ks * 9 + 0) * 32 + cs_] = a0; red[(ks * 9 + 1) * 32 + cs_] = a1; red[(ks * 9 + 2) * 32 + cs_] = a2;
        red[(ks * 9 + 3) * 32 + cs_] = a3; red[(ks * 9 + 4) * 32 + cs_] = a4; red[(ks * 9 + 5) * 32 + cs_] = a5;
        red[(ks * 9 + 6) * 32 + cs_] = a6; red[(ks * 9 + 7) * 32 + cs_] = a7; red[(ks * 9 + 8) * 32 + cs_] = a8;
        __syncthreads();
        if (tid < 288) {
          int m = tid >> 5, c = tid & 31;
          float s = 0.f;
#pragma unroll
          for (int k2 = 0; k2 < 16; ++k2) s += red[(k2 * 9 + m) * 32 + c];
          MODALL[(size_t)(l * 9 + m) * 6144 + n0 + c] = s + p.b_ada[l * 6144 + n0 + c];
        }
        __syncthreads();
      }
    }
    __syncthreads();
    PH(11) convert_layer(p, 0, (float*)smem_raw, tid);
  }
  grid.sync();

  for (int l = 0; l < 2; ++l) {
    const float* MOD = MODALL + (size_t)l * 9 * 6144;
    if (l == 1) PH(11) convert_layer(p, 1, (float*)smem_raw, tid);
    PH(12) norm_phase(p, l, 0, l == 0, tid);
    GSYNC();

    float* const OUTP = p.out;
    PH(1) run_gemm(lds, HBUF, 1024, WT + WT_IN, 1024, 5120, 1024, [=](int row, int col, f32x4 v) {
      if (col < 512) {
        const float qs = 0.125f * 1.4426950408889634f;
        uint2 o; o.x = pack2(v[0] * qs, v[1] * qs); o.y = pack2(v[2] * qs, v[3] * qs);
        *(uint2*)(QB + (size_t)row * 512 + col) = o;
      } else if (col < 1024) {
        uint2 o; o.x = pack2(v[0], v[1]); o.y = pack2(v[2], v[3]);
        *(uint2*)(KB + (size_t)row * 512 + col - 512) = o;
        if (row < 8192) {
          int b = row >> 8, t = row & 255;
          *(f32x4*)(OUTP + OUT_NEWK + ((size_t)((b * 2 + l) * 256 + t)) * 512 + (col - 512)) = v;
        }
      } else if (col < 1536) {
        int c = col - 1024, h = c >> 6, d = c & 63;
        if (row < 8192) {
          int b = row >> 8, t = row & 255;
          bf16_t* vp = VTC + ((size_t)((b * 8 + h) * 64 + d)) * 256 + t;
          vp[0] = f2bf(v[0]); vp[256] = f2bf(v[1]); vp[512] = f2bf(v[2]); vp[768] = f2bf(v[3]);
          *(f32x4*)(OUTP + OUT_NEWV + ((size_t)((b * 2 + l) * 256 + t)) * 512 + c) = v;
        } else {
          int b = (row - 8192) >> 10, t = (row - 8192) & 1023;
          bf16_t* vp = VTL + ((size_t)((b * 8 + h) * 64 + d)) * 1024 + t;
          vp[0] = f2bf(v[0]); vp[1024] = f2bf(v[1]); vp[2048] = f2bf(v[2]); vp[3072] = f2bf(v[3]);
        }
      } else if (col < 2048) {
        uint2 o; o.x = pack2(v[0], v[1]); o.y = pack2(v[2], v[3]);
        bf16_t* dst = col < 1792 ? U + (size_t)row * 256 + (col - 1536) : XR + (size_t)row * 256 + (col - 1792);
        *(uint2*)dst = o;
      } else {
        uint32_t q0 = (uint32_t)(sigmoidf_(v[0]) * 255.f + 0.5f), q1 = (uint32_t)(sigmoidf_(v[1]) * 255.f + 0.5f);
        uint32_t q2 = (uint32_t)(sigmoidf_(v[2]) * 255.f + 0.5f), q3 = (uint32_t)(sigmoidf_(v[3]) * 255.f + 0.5f);
        *(uint32_t*)(G8 + (size_t)row * 3072 + (col - 2048)) = q0 | (q1 << 8) | (q2 << 16) | (q3 << 24);
      }
    });
    GSYNC();

    PH(15) run_gemm(lds, HBUF, 1024, WT + WT_IN + (size_t)5120 * 1024, 1024, 256, 1024, [=](int row, int col, f32x4 v) {
      uint2 o; o.x = pack2(v[0], v[1]); o.y = pack2(v[2], v[3]);
      *(uint2*)(XG + (size_t)row * 256 + col) = o;
    }, 64);
    PH(2) for (;;) {
      LAUNDER_TID();
      if (tid == 0) xb_st[2] = xb_add(&BAR[XB_WQ(l * 2 + 0)], 1u);
      __syncthreads();
      const int item0 = (int)xb_st[2];
      __syncthreads();
      if (item0 >= 800 * (((REP_MASK >> 2) & 1) + 1)) break;
      int item = item0 % 800;
      int kind, sub;
      if (item < 32) { kind = 0; sub = 128 + item; }
      else if (item < 288) { kind = 1; sub = item - 32; }
      else if (item < 416) { kind = 0; sub = item - 288; }
      else if (item < 672) { kind = 2; sub = item - 416; }
      else { kind = 3; sub = item - 672; }
      if (kind == 0) {
        int s = sub >> 2, gq = sub & 3;
        int g = gq * 4 + (wave >> 1), dir = wave & 1;
        int L = s < 32 ? 256 : 1024;
        int row0 = s < 32 ? s * 256 : 8192 + (s - 32) * 1024;
        float* BUs = (float*)(smem_raw + wave * S5_WAVE_BYTES);
        bf16_t* Hs = (bf16_t*)(smem_raw + wave * S5_WAVE_BYTES + 8448);
        float lbr, lbi;
        {
          float cr, ci;
          s5_disc(p, l, dir, g, lane, lbr, lbi, cr, ci);
        }
        bf16x8 bfrag[8];
#pragma unroll
        for (int nb = 0; nb < 4; ++nb) {
          int n2 = nb * 16 + l15;
          float t0, t1, cr, ci;
          s5_disc(p, l, dir, g, n2, t0, t1, cr, ci);
          union { uint4 u; bf16x8 v; } fr_, fi_;
          fr_.u = make_uint4(0, 0, 0, 0); fi_.u = make_uint4(0, 0, 0, 0);
          if (quad < 2) {
            const float* br = p.s5_b_re + ((size_t)(l * 16 + g) * 64 + n2) * 16 + quad * 8;
            const float* bi = p.s5_b_im + ((size_t)(l * 16 + g) * 64 + n2) * 16 + quad * 8;
            float4 r0 = *(const float4*)br, r1 = *(const float4*)(br + 4);
            float4 i0 = *(const float4*)bi, i1 = *(const float4*)(bi + 4);
            fr_.u.x = pack2(cr * r0.x - ci * i0.x, cr * r0.y - ci * i0.y);
            fr_.u.y = pack2(cr * r0.z - ci * i0.z, cr * r0.w - ci * i0.w);
            fr_.u.z = pack2(cr * r1.x - ci * i1.x, cr * r1.y - ci * i1.y);
            fr_.u.w = pack2(cr * r1.z - ci * i1.z, cr * r1.w - ci * i1.w);
            fi_.u.x = pack2(cr * i0.x + ci * r0.x, cr * i0.y + ci * r0.y);
            fi_.u.y = pack2(cr * i0.z + ci * r0.z, cr * i0.w + ci * r0.w);
            fi_.u.z = pack2(cr * i1.x + ci * r1.x, cr * i1.y + ci * r1.y);
            fi_.u.w = pack2(cr * i1.z + ci * r1.z, cr * i1.w + ci * r1.w);
          }
          bfrag[nb] = fr_.v; bfrag[4 + nb] = fi_.v;
        }
        bf16x8 cfrag[4];
#pragma unroll
        for (int ks = 0; ks < 4; ++ks) {
          const float* cp = (ks < 2 ? p.s5_c_re : p.s5_c_im) + (size_t)((l * 2 + dir) * 16 + g) * 1024 + l15 * 64 + (ks & 1) * 32 + quad * 8;
          float sg = ks < 2 ? 1.f : -1.f;
          float4 c0 = *(const float4*)cp, c1 = *(const float4*)(cp + 4);
          union { uint4 u; bf16x8 v; } cf;
          cf.u.x = pack2(sg * c0.x, sg * c0.y); cf.u.y = pack2(sg * c0.z, sg * c0.w);
          cf.u.z = pack2(sg * c1.x, sg * c1.y); cf.u.w = pack2(sg * c1.z, sg * c1.w);
          cfrag[ks] = cf.v;
        }
        float hr = 0.f, hi = 0.f;
        if (s >= 32) {
          int si = ((((s - 32) * 2 + l) * 2 + dir) * 16 + g) * 64 + lane;
          hr = p.st_s5_re[si]; hi = p.st_s5_im[si];
        }
        bf16_t* ydst = dir == 0 ? S5Y : MG;
        __syncthreads();
        auto load_u = [&](int kb) -> uint4 {
          uint4 r = make_uint4(0, 0, 0, 0);
          int k = kb * 16 + l15;
          int t = dir ? (L - 1 - k) : k;
          if (quad < 2) r = *(const uint4*)(U + (size_t)(row0 + t) * 256 + g * 16 + quad * 8);
          return r;
        };
        uint4 ucur = load_u(0);
        const int nkb = L / 16;
        for (int kb = 0; kb < nkb; ++kb) {
          uint4 unext = make_uint4(0, 0, 0, 0);
          if (kb + 1 < nkb) unext = load_u(kb + 1);
          union { uint4 u; bf16x8 v; } uf;
          uf.u = ucur;
#pragma unroll
          for (int cb = 0; cb < 8; ++cb) {
            f32x4 a = {0.f, 0.f, 0.f, 0.f};
            a = __builtin_amdgcn_mfma_f32_16x16x32_bf16(uf.v, bfrag[cb], a, 0, 0, 0);
#pragma unroll
            for (int e = 0; e < 4; ++e) BUs[(quad * 4 + e) * S5_BUS + cb * 16 + l15] = a[e];
          }
          __builtin_amdgcn_wave_barrier();
#pragma unroll
          for (int i = 0; i < 16; ++i) {
            float bur = BUs[i * S5_BUS + lane], bui = BUs[i * S5_BUS + 64 + lane];
            float nr = lbr * hr - lbi * hi + bur;
            float ni = lbr * hi + lbi * hr + bui;
            hr = nr; hi = ni;
            Hs[i * S5_HS + lane] = f2bf(hr);
            Hs[i * S5_HS + 64 + lane] = f2bf(hi);
          }
          __builtin_amdgcn_wave_barrier();
          {
            f32x4 y = {0.f, 0.f, 0.f, 0.f};
#pragma unroll
            for (int ks = 0; ks < 4; ++ks) {
              bf16x8 hf = *(const bf16x8*)(Hs + l15 * S5_HS + ks * 32 + quad * 8);
              y = __builtin_amdgcn_mfma_f32_16x16x32_bf16(hf, cfrag[ks], y, 0, 0, 0);
            }
#pragma unroll
            for (int e = 0; e < 4; ++e) {
              int k = kb * 16 + quad * 4 + e;
              int t = dir ? (L - 1 - k) : k;
              ydst[(size_t)(row0 + t) * 256 + g * 16 + l15] = f2bf(y[e]);
            }
          }
          __builtin_amdgcn_wave_barrier();
          ucur = unext;
        }
        if (s < 32) {
          int oi = (((s * 2 + l) * 2 + dir) * 16 + g) * 64 + lane;
          p.out[OUT_S5RE + oi] = hr;
          p.out[OUT_S5IM + oi] = hi;
        }
        __syncthreads();
        {
          const float* dptr = p.s5_d + l * 256 + gq * 64;
#pragma unroll 4
          for (int idx = tid; idx < L * 8; idx += 512) {
            int t = idx >> 3, c8 = (idx & 7) * 8;
            size_t off = (size_t)(row0 + t) * 256 + gq * 64 + c8;
            uint4 yf = *(const uint4*)(S5Y + off), yb = *(const uint4*)(MG + off), uu = *(const uint4*)(U + off);
            float4 d0 = *(const float4*)(dptr + c8), d1 = *(const float4*)(dptr + c8 + 4);
            uint4 o;
            o.x = pack2(gelu_(lo2f(yf.x) + lo2f(yb.x) + d0.x * lo2f(uu.x)), gelu_(hi2f(yf.x) + hi2f(yb.x) + d0.y * hi2f(uu.x)));
            o.y = pack2(gelu_(lo2f(yf.y) + lo2f(yb.y) + d0.z * lo2f(uu.y)), gelu_(hi2f(yf.y) + hi2f(yb.y) + d0.w * hi2f(uu.y)));
            o.z = pack2(gelu_(lo2f(yf.z) + lo2f(yb.z) + d1.x * lo2f(uu.z)), gelu_(hi2f(yf.z) + hi2f(yb.z) + d1.y * hi2f(uu.z)));
            o.w = pack2(gelu_(lo2f(yf.w) + lo2f(yb.w) + d1.z * lo2f(uu.w)), gelu_(hi2f(yf.w) + hi2f(yb.w) + d1.w * hi2f(uu.w)));
            *(uint4*)(S5Y + off) = o;
          }
        }
        __syncthreads();
      } else if (kind == 1 || kind == 2) {
        bf16_t* KS = (bf16_t*)smem_raw;
        bf16_t* VS = (bf16_t*)(smem_raw + 65536);
        int b, h, nkeys, vss, kgld, rp = 0;
        const bf16_t *kg, *vg;
        if (kind == 2) { h = sub & 7; b = sub >> 3; nkeys = 256; vss = 264; kg = KB + (size_t)(b * 256) * 512 + h * 64; kgld = 512; vg = VTC + (size_t)((b * 8 + h) * 64) * 256; }
        else { rp = sub & 3; h = (sub >> 2) & 7; b = sub >> 5; nkeys = 512; vss = 520; kg = KC + (size_t)((b * 8 + h) * 512) * 64; kgld = 64; vg = VCT + (size_t)((b * 8 + h) * 64) * 512; }
        for (int idx = tid; idx < nkeys * 8; idx += 512) {
          int key = idx >> 3, ch = idx & 7;
          uint4 v = *(const uint4*)(kg + (size_t)key * kgld + ch * 8);
          *(uint4*)(KS + key * 64 + ((ch ^ (key & 7)) * 8)) = v;
        }
        {
          const int cpr = nkeys >> 3, sh = (kind == 2) ? 5 : 6;
          for (int idx = tid; idx < 64 * cpr; idx += 512) {
            int d = idx >> sh, ch = idx & (cpr - 1);
            uint4 v = *(const uint4*)(vg + (size_t)d * nkeys + ch * 8);
            *(uint4*)(VS + d * vss + ch * 8) = v;
          }
        }
        __syncthreads();
        {
          AttnState st0, st1;
#pragma unroll
          for (int db = 0; db < 4; ++db) { st0.o[db] = f32x4{0.f, 0.f, 0.f, 0.f}; st1.o[db] = f32x4{0.f, 0.f, 0.f, 0.f}; }
          st0.m = -1e30f; st0.lsum = 0.f; st1.m = -1e30f; st1.lsum = 0.f;
          bf16x8 qf0[2], qf1[2];
          bf16_t *orow0, *orow1;
          int r0 = 0, r1 = 0, j = 0, band0 = 0, qcol = 0, win0 = 0, nloc = 0;
          const float* rp_ = p.rpb;
          int tok0 = 0;
          if (kind == 2) {
            orow0 = QB + (size_t)(b * 256 + wave * 16 + l15) * 512 + h * 64;
            orow1 = orow0 + (size_t)128 * 512;
          } else {
            r0 = rp * 4 + (wave >> 2) * 2; r1 = r0 + 1;
            j = wave & 3;
            tok0 = 8192 + b * 1024;
            orow0 = QB + (size_t)(tok0 + r0 * 64 + j * 16 + l15) * 512 + h * 64;
            orow1 = orow0 + (size_t)64 * 512;
            band0 = min(max(j * 16 - 8, 0), 32);
            qcol = j * 16 + l15;
            win0 = min(max(qcol - 8, 0), 48);
            rp_ = p.rpb + (size_t)(l * 8 + h) * 15 * 31;
            nloc = 8;
          }
          qf0[0] = *(const bf16x8*)(orow0 + quad * 8); qf0[1] = *(const bf16x8*)(orow0 + 32 + quad * 8);
          qf1[0] = *(const bf16x8*)(orow1 + quad * 8); qf1[1] = *(const bf16x8*)(orow1 + 32 + quad * 8);
          auto softmax_pv = [&](AttnState& st, float (&sc_)[8], const bf16x8 (&va)[4]) {
            float tm = sc_[0];
#pragma unroll
            for (int i = 1; i < 8; ++i) tm = fmaxf(tm, sc_[i]);
            tm = quad_max(tm);
            if (__builtin_amdgcn_ballot_w64(tm > st.m + 8.f)) {
              float mn = fmaxf(st.m, tm);
              float alpha = __builtin_amdgcn_exp2f(st.m - mn);
              st.m = mn;
              st.lsum *= alpha;
#pragma unroll
              for (int db = 0; db < 4; ++db) { st.o[db][0] *= alpha; st.o[db][1] *= alpha; st.o[db][2] *= alpha; st.o[db][3] *= alpha; }
            }
            float pv[8];
            float ps = 0.f;
#pragma unroll
            for (int i = 0; i < 8; ++i) { pv[i] = __builtin_amdgcn_exp2f(sc_[i] - st.m); ps += pv[i]; }
            st.lsum += ps;
            union { uint4 u; bf16x8 v; } pb;
            pb.u.x = pack2(pv[0], pv[1]); pb.u.y = pack2(pv[2], pv[3]); pb.u.z = pack2(pv[4], pv[5]); pb.u.w = pack2(pv[6], pv[7]);
#pragma unroll
            for (int db = 0; db < 4; ++db) st.o[db] = __builtin_amdgcn_mfma_f32_16x16x32_bf16(va[db], pb.v, st.o[db], 0, 0, 0);
          };
          const int nct = nkeys >> 5;
          for (int t = 0; t < nct; ++t) {
            bf16x8 kf[4];
#pragma unroll
            for (int half = 0; half < 2; ++half) {
              int key = t * 32 + half * 16 + l15;
              const bf16_t* kr = KS + key * 64;
              kf[half * 2] = *(const bf16x8*)(kr + ((quad ^ (key & 7)) * 8));
              kf[half * 2 + 1] = *(const bf16x8*)(kr + (((quad + 4) ^ (key & 7)) * 8));
            }
            bf16x8 va[4];
#pragma unroll
            for (int db = 0; db < 4; ++db) {
              const bf16_t* vp = VS + (db * 16 + l15) * vss + t * 32 + quad * 4;
              uint2 lo = *(const uint2*)vp, hi = *(const uint2*)(vp + 16);
              union { uint4 u; bf16x8 v; } x; x.u.x = lo.x; x.u.y = lo.y; x.u.z = hi.x; x.u.w = hi.y;
              va[db] = x.v;
            }
            float sa[8], sb[8];
#pragma unroll
            for (int half = 0; half < 2; ++half) {
              f32x4 a0 = {0.f, 0.f, 0.f, 0.f}, a1 = {0.f, 0.f, 0.f, 0.f};
              a0 = __builtin_amdgcn_mfma_f32_16x16x32_bf16(kf[half * 2], qf0[0], a0, 0, 0, 0);
              a1 = __builtin_amdgcn_mfma_f32_16x16x32_bf16(kf[half * 2], qf1[0], a1, 0, 0, 0);
              a0 = __builtin_amdgcn_mfma_f32_16x16x32_bf16(kf[half * 2 + 1], qf0[1], a0, 0, 0, 0);
              a1 = __builtin_amdgcn_mfma_f32_16x16x32_bf16(kf[half * 2 + 1], qf1[1], a1, 0, 0, 0);
#pragma unroll
              for (int e = 0; e < 4; ++e) { sa[half * 4 + e] = a0[e]; sb[half * 4 + e] = a1[e]; }
            }
            softmax_pv(st0, sa, va);
            softmax_pv(st1, sb, va);
          }
          if (nloc) {
            const int rb0 = min(max(r0 - 4, 0), 8), rb1 = min(max(r1 - 4, 0), 8);
            const int nu = rb1 + 8 - rb0;
            const bf16_t* k2 = KB + (size_t)(tok0 + rb0 * 64 + band0) * 512 + h * 64;
            const bf16_t* v2 = VTL + (size_t)((b * 8 + h) * 64) * 1024 + rb0 * 64 + band0;
            auto load_k = [&](int u, bf16x8 (&kk)[4]) {
              const bf16_t* kb_ = k2 + (size_t)(u * 64) * 512;
#pragma unroll
              for (int half = 0; half < 2; ++half) {
                const bf16_t* kp = kb_ + (size_t)(half * 16 + l15) * 512 + quad * 8;
                kk[half * 2] = *(const bf16x8*)kp;
                kk[half * 2 + 1] = *(const bf16x8*)(kp + 32);
              }
            };
            auto scores = [&](const bf16x8 (&qf)[2], const bf16x8 (&kk)[4], float (&sc_)[8]) {
#pragma unroll
              for (int half = 0; half < 2; ++half) {
                f32x4 acc = {0.f, 0.f, 0.f, 0.f};
                acc = __builtin_amdgcn_mfma_f32_16x16x32_bf16(kk[half * 2], qf[0], acc, 0, 0, 0);
                acc = __builtin_amdgcn_mfma_f32_16x16x32_bf16(kk[half * 2 + 1], qf[1], acc, 0, 0, 0);
#pragma unroll
                for (int e = 0; e < 4; ++e) sc_[half * 4 + e] = acc[e];
              }
            };
            auto finish = [&](AttnState& st, int r, int rr, float (&sc_)[8], const bf16x8 (&va)[4]) {
              int dy = rr - r + 7;
#pragma unroll
              for (int i = 0; i < 8; ++i) {
                int kc = band0 + (i >> 2) * 16 + quad * 4 + (i & 3);
                bool valid = (kc >= win0) && (kc < win0 + 16);
                int dx = min(max(kc - qcol + 15, 0), 30);
                float bias = rp_[dy * 31 + dx] * 1.4426950408889634f;
                sc_[i] = valid ? sc_[i] + bias : -1e30f;
              }
              softmax_pv(st, sc_, va);
            };
            bf16x8 kk[4];
            load_k(0, kk);
#pragma unroll 1
            for (int u = 0; u < nu; ++u) {
              bf16x8 va[4];
              {
                const bf16_t* vt_ = v2 + u * 64;
#pragma unroll
                for (int db = 0; db < 4; ++db) {
                  const bf16_t* vp = vt_ + (size_t)(db * 16 + l15) * 1024 + quad * 4;
                  uint2 lo = *(const uint2*)vp, hi = *(const uint2*)(vp + 16);
                  union { uint4 u4; bf16x8 v; } x; x.u4.x = lo.x; x.u4.y = lo.y; x.u4.z = hi.x; x.u4.w = hi.y;
                  va[db] = x.v;
                }
              }
              const int rr = rb0 + u;
              const bool t0 = u < 8, t1 = rr >= rb1;
              float sa[8], sb[8];
#pragma unroll
              for (int i = 0; i < 8; ++i) { sa[i] = -1e30f; sb[i] = -1e30f; }
              if (t0) scores(qf0, kk, sa);
              if (t1) scores(qf1, kk, sb);
              if (u + 1 < nu) load_k(u + 1, kk);
              if (t0) finish(st0, r0, rr, sa, va);
              if (t1) finish(st1, r1, rr, sb, va);
            }
          }
          {
            float inv0 = __builtin_amdgcn_rcpf(quad_sum(st0.lsum)), inv1 = __builtin_amdgcn_rcpf(quad_sum(st1.lsum));
#pragma unroll
            for (int db = 0; db < 4; ++db) {
              uint2 pk;
              pk.x = pack2(st0.o[db][0] * inv0, st0.o[db][1] * inv0);
              pk.y = pack2(st0.o[db][2] * inv0, st0.o[db][3] * inv0);
              *(uint2*)(orow0 + db * 16 + quad * 4) = pk;
              pk.x = pack2(st1.o[db][0] * inv1, st1.o[db][1] * inv1);
              pk.y = pack2(st1.o[db][2] * inv1, st1.o[db][3] * inv1);
              *(uint2*)(orow1 + db * 16 + quad * 4) = pk;
            }
          }
        }
      } else {
        int ch = tid & 255;
        int r0 = sub * 128 + (tid >> 8) * 64;
        int L = r0 < 8192 ? 256 : 1024;
        float w0 = p.lru_conv_w[l * 1024 + ch], w1 = p.lru_conv_w[l * 1024 + 256 + ch];
        float w2 = p.lru_conv_w[l * 1024 + 512 + ch], w3 = p.lru_conv_w[l * 1024 + 768 + ch];
        float cb = p.lru_conv_b[l * 256 + ch];
#pragma unroll 1
        for (int c0 = 0; c0 < 64; c0 += 16) {
          int rc = r0 + c0;
          int tc = rc & (L - 1);
          const bf16_t* xp = XR + (size_t)rc * 256 + ch;
          float xv[19];
#pragma unroll
          for (int i = 0; i < 19; ++i) {
            int tt = tc + i - 2;
            xv[i] = (tt >= 0 && tt < L) ? bf2f(xp[(i - 2) * 256]) : 0.f;
          }
#pragma unroll
          for (int i = 0; i < 16; ++i)
            LRUY[(size_t)(rc + i) * 256 + ch] = f2bf(cb + w0 * xv[i] + w1 * xv[i + 1] + w2 * xv[i + 2] + w3 * xv[i + 3]);
        }
      }
    }
    GSYNC();

    const float* const lba = p.lru_b_a + l * 512;
    const float* const lbx = p.lru_b_x + l * 512;
    PH(3) run_gemm(lds, LRUY, 256, WT + WT_LRU, 256, 1024, 256, [=](int row, int col, f32x4 v) {
      int dir = col >> 9, gate = (col >> 8) & 1, ch = col & 255;
      f32x4 bias = *(const f32x4*)((gate ? lbx : lba) + dir * 256 + ch);
      float s0 = sigmoidf_(v[0] + bias[0]), s1 = sigmoidf_(v[1] + bias[1]), s2 = sigmoidf_(v[2] + bias[2]), s3 = sigmoidf_(v[3] + bias[3]);
      if (gate) {
        uint2 xc = *(const uint2*)(LRUY + (size_t)row * 256 + ch);
        s0 *= lo2f(xc.x); s1 *= hi2f(xc.x); s2 *= lo2f(xc.y); s3 *= hi2f(xc.y);
      }
      uint2 o; o.x = pack2(s0, s1); o.y = pack2(s2, s3);
      *(uint2*)(MG + (size_t)row * 1024 + col) = o;
    });
    __builtin_amdgcn_sched_barrier(0);
    __builtin_amdgcn_sched_barrier(0);
    PH(10) run_gemm(lds, S5Y, 256, WT + WT_GLU, 256, 256, 256, [=](int row, int col, f32x4 v) {
      uint2 yy = *(const uint2*)(S5Y + (size_t)row * 256 + col);
      uint2 o;
      o.x = pack2(lo2f(yy.x) * sigmoidf_(v[0]), hi2f(yy.x) * sigmoidf_(v[1]));
      o.y = pack2(lo2f(yy.y) * sigmoidf_(v[2]), hi2f(yy.y) * sigmoidf_(v[3]));
      *(uint2*)(U + (size_t)row * 256 + col) = o;
    });
    GSYNC();

    PH(4) for (;;) {
      LAUNDER_TID();
      if (tid == 0) xb_st[2] = xb_add(&BAR[XB_WQ(l * 2 + 1)], 1u);
      __syncthreads();
      const int qi = (int)xb_st[2];
      __syncthreads();
      if (qi >= 320) break;
      const int item = qi < 64 ? 256 + qi : qi - 64;
      const int s = item >> 3, ch0 = (item & 7) * 32;
      const int L = s < 32 ? 256 : 1024;
      const int Lq = L >> 3;
      const int row0 = s < 32 ? s * 256 : 8192 + (s - 32) * 1024;
      const int dir = lane >> 5, q = wave;
      const int ch = ch0 + (lane & 31);
      float* E_ = (float*)smem_raw;
      float* PT = E_ + 512;
      float* CAR = PT + 512;
      float lam = p.lru_lam[l * 512 + dir * 256 + ch];
      float sp = log1pf(expf(-lam));
      float h = 0.f, P = 1.f;
      bf16_t* base = MG + dir * 512 + ch;
      {
        const int kbeg = q * Lq, kend = (q + 1) * Lq;
        uint32_t cur[8], nxt[8];
        auto ld8 = [&](int kb, uint32_t (&d)[8]) {
#pragma unroll
          for (int i = 0; i < 8; ++i) {
            int k = kb + i;
            int t = dir ? (L - 1 - k) : k;
            const bf16_t* qq = base + (size_t)(row0 + t) * 1024;
            d[i] = (uint32_t)qq[0] | ((uint32_t)qq[256] << 16);
          }
        };
        ld8(kbeg, cur);
        for (int kb = kbeg; kb < kend; kb += 8) {
          if (kb + 8 < kend) ld8(kb + 8, nxt);
          float hv[8], pv_[8];
#pragma unroll
          for (int i = 0; i < 8; ++i) {
            float rvv = lo2f(cur[i]), xvv = hi2f(cur[i]);
            float la = -8.f * rvv * sp;
            float a = __expf(la);
            float x2 = 2.f * la;
            float ser = -x2 * (1.f + x2 * (0.5f + x2 * (0.16666667f + x2 * (0.041666668f + x2 * (0.0083333338f + x2 * 0.0013888889f)))));
            float om = x2 > -0.25f ? ser : 1.f - a * a;
            float bm = __builtin_amdgcn_sqrtf(fmaxf(om, 0.f)) * xvv;
            h = a * h + bm;
            P = a * P;
            hv[i] = h; pv_[i] = P;
          }
#pragma unroll
          for (int i = 0; i < 8; ++i) {
            int k = kb + i;
            int t = dir ? (L - 1 - k) : k;
            bf16_t* qq = base + (size_t)(row0 + t) * 1024;
            uint32_t pk = pack2(hv[i], pv_[i]);
            qq[0] = (bf16_t)(pk & 0xffffu);
            qq[256] = (bf16_t)(pk >> 16);
          }
#pragma unroll
          for (int i = 0; i < 8; ++i) cur[i] = nxt[i];
        }
      }
      E_[wave * 64 + lane] = h;
      PT[wave * 64 + lane] = P;
      __syncthreads();
      {
        float c = 0.f;
        if (s >= 32) c = p.st_lru[(((s - 32) * 2 + l) * 2 + dir) * 256 + ch];
        for (int q2 = 0; q2 < q; ++q2) c = PT[q2 * 64 + lane] * c + E_[q2 * 64 + lane];
        CAR[wave * 64 + lane] = c;
        if (q == 7 && s < 32) p.out[OUT_LRU + ((s * 2 + l) * 2 + dir) * 256 + ch] = P * c + h;
      }
      __syncthreads();
      {
#pragma unroll 2
        for (int idx = tid; idx < L * 4; idx += 512) {
          int t = idx >> 2, c8 = (idx & 3) * 8;
          int qf_ = t / Lq, qb_ = (L - 1 - t) / Lq;
          size_t row = row0 + t;
          const bf16_t* mp = MG + row * 1024 + ch0 + c8;
          uint4 h0 = *(const uint4*)mp, p0 = *(const uint4*)(mp + 256), h1 = *(const uint4*)(mp + 512), p1 = *(const uint4*)(mp + 768);
          uint4 gg = *(const uint4*)(XG + row * 256 + ch0 + c8);
          const float* cf = CAR + qf_ * 64 + c8;
          const float* cbk = CAR + qb_ * 64 + 32 + c8;
          float4 cf0 = *(const float4*)cf, cf1 = *(const float4*)(cf + 4), cb0 = *(const float4*)cbk, cb1 = *(const float4*)(cbk + 4);
          uint4 o;
          o.x = pack2((lo2f(h0.x) + lo2f(p0.x) * cf0.x + lo2f(h1.x) + lo2f(p1.x) * cb0.x) * gelu_(lo2f(gg.x)),
                      (hi2f(h0.x) + hi2f(p0.x) * cf0.y + hi2f(h1.x) + hi2f(p1.x) * cb0.y) * gelu_(hi2f(gg.x)));
          o.y = pack2((lo2f(h0.y) + lo2f(p0.y) * cf0.z + lo2f(h1.y) + lo2f(p1.y) * cb0.z) * gelu_(lo2f(gg.y)),
                      (hi2f(h0.y) + hi2f(p0.y) * cf0.w + hi2f(h1.y) + hi2f(p1.y) * cb0.w) * gelu_(hi2f(gg.y)));
          o.z = pack2((lo2f(h0.z) + lo2f(p0.z) * cf1.x + lo2f(h1.z) + lo2f(p1.z) * cb1.x) * gelu_(lo2f(gg.z)),
                      (hi2f(h0.z) + hi2f(p0.z) * cf1.y + hi2f(h1.z) + hi2f(p1.z) * cb1.y) * gelu_(hi2f(gg.z)));
          o.w = pack2((lo2f(h0.w) + lo2f(p0.w) * cf1.z + lo2f(h1.w) + lo2f(p1.w) * cb1.z) * gelu_(lo2f(gg.w)),
                      (hi2f(h0.w) + hi2f(p0.w) * cf1.w + hi2f(h1.w) + hi2f(p1.w) * cb1.w) * gelu_(hi2f(gg.w)));
          *(uint4*)(LRUY + row * 256 + ch0 + c8) = o;
        }
      }
      __syncthreads();
    }
    GSYNC();

    PH(5) {
      pg8::StaticOrder S; S.init(16384, 1024, gridDim.x, blockIdx.x);
      int k0 = 512, k12 = 256;
      asm volatile("" : "+s"(k0), "+s"(k12));
      const unsigned char* const Gp = G8;
      bf16_t* const MGp = MG;
      pg8::gemm_phase_seg(lds, QB, U, LRUY, WT + WT_BRA, WT + WT_BRS, WT + WT_BRL, k0, k12, S,
        pg8::make_epi_seg(
          [=](int row, int col, int seg) -> uint2 {
            const unsigned char* gp = Gp + (size_t)row * 3072 + col;
            uint2 r;
            r.x = *(const uint32_t*)(gp + seg * 1024);
            r.y = *(const uint32_t*)(gp + (seg < 2 ? seg + 1 : 2) * 1024);
            return r;
          },
          [=](int row, int col, f32x4& v, int seg, uint2 g) {
          const uint32_t ga = g.x, gb = g.y;
          float a0 = (float)max((int)(ga & 255u), 1), a1 = (float)max((int)((ga >> 8) & 255u), 1);
          float a2 = (float)max((int)((ga >> 16) & 255u), 1), a3 = (float)max((int)(ga >> 24), 1);
          if (seg < 2) {
            float b0 = (float)max((int)(gb & 255u), 1), b1 = (float)max((int)((gb >> 8) & 255u), 1);
            float b2 = (float)max((int)((gb >> 16) & 255u), 1), b3 = (float)max((int)(gb >> 24), 1);
            v[0] = v[0] * (a0 * __builtin_amdgcn_rcpf(b0)); v[1] = v[1] * (a1 * __builtin_amdgcn_rcpf(b1)); v[2] = v[2] * (a2 * __builtin_amdgcn_rcpf(b2)); v[3] = v[3] * (a3 * __builtin_amdgcn_rcpf(b3));
          } else {
            const float sc_ = 1.f / 255.f;
            uint2 o; o.x = pack2(v[0] * (a0 * sc_), v[1] * (a1 * sc_)); o.y = pack2(v[2] * (a2 * sc_), v[3] * (a3 * sc_));
            *(uint2*)(MGp + (size_t)row * 1024 + col) = o;
          }
        }));
    }
    GSYNC();

    const float* const xin0 = p.x_prompt;
    const float* const xin1 = p.x_sample;
    PH(6) run_gemm(lds, MG, 1024, WT + WT_OUT, 1024, 1024, 1024, [=](int row, int col, f32x4 v) {
      f32x4 gt = *(const f32x4*)(MOD + (size_t)modrow(row) * 6144 + 2048 + col);
      const float* xs = l == 0 ? (row < 8192 ? xin0 + (size_t)row * 1024 : xin1 + (size_t)(row - 8192) * 1024) : X + (size_t)row * 1024;
      f32x4 xv = *(const f32x4*)(xs + col);
      *(f32x4*)(X + (size_t)row * 1024 + col) = xv + gt * v;
    });
    GSYNC();

    PH(13) norm_phase(p, l, 1, false, tid);
    GSYNC();

    bf16_t* const FAB = (bf16_t*)UB;
    PH(7) run_gemm(lds, HBUF, 1024, WT + WT_UP, 1024, 5632, 1024, [=](int row, int col, f32x4 v) {
      uint2 o; o.x = pack2(v[0], v[1]); o.y = pack2(v[2], v[3]);
      *(uint2*)(FAB + (size_t)row * 5632 + col) = o;
    });
    GSYNC();

    {
      LAUNDER_TID();
      const float* const fcw = p.ffn_conv_w + l * 3 * 2816;
      const float* const fcb = p.ffn_conv_b + l * 2816;
      for (int it = blockIdx.x * 512 + tid; it < 1024 * 352; it += gridDim.x * 512) {
        int rb = it / 352, cc = it - rb * 352;
        int r0 = rb * 16, col = cc * 8;
        int L = r0 < 8192 ? 256 : 1024;
        int t0 = r0 & (L - 1);
        const float* cw = fcw + col;
        float4 w0a = *(const float4*)cw, w0b = *(const float4*)(cw + 4);
        float4 w1a = *(const float4*)(cw + 2816), w1b = *(const float4*)(cw + 2820);
        float4 w2a = *(const float4*)(cw + 5632), w2b = *(const float4*)(cw + 5636);
        float4 cba = *(const float4*)(fcb + col), cbb = *(const float4*)(fcb + col + 4);
        const bf16_t* ap = FAB + (size_t)r0 * 5632 + col;
        bf16_t* bp = FAB + (size_t)r0 * 5632 + 2816 + col;
        uint4 am1 = make_uint4(0, 0, 0, 0);
        if (t0 > 0) am1 = *(const uint4*)(ap - 5632);
        uint4 a0 = *(const uint4*)ap;
        const bool tail_ok = (t0 + 16 < L);
#pragma unroll 1
        for (int i0 = 0; i0 < 16; i0 += 4) {
          uint4 an[4], bb[4];
#pragma unroll
          for (int jj = 0; jj < 4; ++jj) {
            int i = i0 + jj;
            an[jj] = make_uint4(0, 0, 0, 0);
            if (i < 15 || tail_ok) an[jj] = *(const uint4*)(ap + (size_t)(i + 1) * 5632);
            bb[jj] = *(const uint4*)(bp + (size_t)i * 5632);
          }
#pragma unroll
          for (int jj = 0; jj < 4; ++jj) {
            uint4 o;
            {
              float x0 = cba.x + w0a.x * lo2f(am1.x) + w1a.x * lo2f(a0.x) + w2a.x * lo2f(an[jj].x);
              float x1 = cba.y + w0a.y * hi2f(am1.x) + w1a.y * hi2f(a0.x) + w2a.y * hi2f(an[jj].x);
              o.x = pack2(gelu_(x0) * lo2f(bb[jj].x), gelu_(x1) * hi2f(bb[jj].x));
              float x2 = cba.z + w0a.z * lo2f(am1.y) + w1a.z * lo2f(a0.y) + w2a.z * lo2f(an[jj].y);
              float x3 = cba.w + w0a.w * hi2f(am1.y) + w1a.w * hi2f(a0.y) + w2a.w * hi2f(an[jj].y);
              o.y = pack2(gelu_(x2) * lo2f(bb[jj].y), gelu_(x3) * hi2f(bb[jj].y));
              float x4 = cbb.x + w0b.x * lo2f(am1.z) + w1b.x * lo2f(a0.z) + w2b.x * lo2f(an[jj].z);
              float x5 = cbb.y + w0b.y * hi2f(am1.z) + w1b.y * hi2f(a0.z) + w2b.y * hi2f(an[jj].z);
              o.z = pack2(gelu_(x4) * lo2f(bb[jj].z), gelu_(x5) * hi2f(bb[jj].z));
              float x6 = cbb.z + w0b.z * lo2f(am1.w) + w1b.z * lo2f(a0.w) + w2b.z * lo2f(an[jj].w);
              float x7 = cbb.w + w0b.w * hi2f(am1.w) + w1b.w * hi2f(a0.w) + w2b.w * hi2f(an[jj].w);
              o.w = pack2(gelu_(x6) * lo2f(bb[jj].w), gelu_(x7) * hi2f(bb[jj].w));
            }
            *(uint4*)(bp + (size_t)(i0 + jj) * 5632) = o;
            am1 = a0; a0 = an[jj];
          }
        }
      }
    }
    GSYNC();

    PH(9) run_gemm(lds, FAB + 2816, 5632, WT + WT_DOWN, 2816, 1024, 2816, [=](int row, int col, f32x4 v) {
      f32x4 gt = *(const f32x4*)(MOD + (size_t)modrow(row) * 6144 + 5120 + col);
      f32x4* xp = (f32x4*)(X + (size_t)row * 1024 + col);
      *xp = *xp + gt * v;
    });
    GSYNC();
  }

  {
  LAUNDER_TID();
  for (int r = blockIdx.x * 8 + wave; r < 16384; r += gridDim.x * 8) {
    float* xr = X + (size_t)r * 1024;
    float4 v[4];
    float ss = 0.f;
#pragma unroll
    for (int i = 0; i < 4; ++i) {
      v[i] = *(const float4*)(xr + i * 256 + lane * 4);
      ss += v[i].x * v[i].x + v[i].y * v[i].y + v[i].z * v[i].z + v[i].w * v[i].w;
    }
#pragma unroll
    for (int o = 32; o >= 1; o >>= 1) ss += __shfl_xor(ss, o);
    float rstd = rsqrtf(ss * (1.f / 1024.f) + 1e-6f);
#pragma unroll
    for (int i = 0; i < 4; ++i) {
      int c = i * 256 + lane * 4;
      float4 gg = *(const float4*)(p.g_final + c);
      float4 o;
      o.x = v[i].x * rstd * gg.x; o.y = v[i].y * rstd * gg.y; o.z = v[i].z * rstd * gg.z; o.w = v[i].w * rstd * gg.w;
      *(float4*)(xr + c) = o;
    }
  }
  }
}

extern "C" void kernel_launch(void* const* d_in, const int* in_sizes, int n_in, void* d_out, int out_size, void* d_ws,
                              size_t ws_size, hipStream_t stream) {
  static int grid_blocks = 0;
  if (!grid_blocks) {
    int dev = 0, cus = 0;
    (void)hipGetDevice(&dev);
    (void)hipDeviceGetAttribute(&cus, hipDeviceAttributeMultiprocessorCount, dev);
    (void)hipFuncSetAttribute((const void*)mega, hipFuncAttributeMaxDynamicSharedMemorySize, LDS_BYTES);
    int per_cu = 0;
    (void)hipOccupancyMaxActiveBlocksPerMultiprocessor(&per_cu, (const void*)mega, 512, LDS_BYTES);
    (void)hipGetLastError();
    grid_blocks = cus > 0 ? cus : 256;
  }
  Params p{};
  const float** pp = (const float**)&p;
  for (int i = 0; i < 40; ++i) pp[i] = (const float*)d_in[i];
  p.out = (float*)d_out;
  p.ws = (char*)d_ws;
  (void)hipMemsetAsync((char*)d_ws + WS_BAR, 0, XCD_BAR_WORDS * 4, stream);
  void* args[] = {&p};
  hipError_t e = hipLaunchCooperativeKernel((const void*)mega, dim3(grid_blocks), dim3(512), args, LDS_BYTES, stream);
  if (e != hipSuccess) fprintf(stderr, "cooperative launch failed: %s (grid %d)\n", hipGetErrorString(e), grid_blocks);
}
```
